# Optimizing an MI355X kernel written in HIP

```python
import math
import jax, jax.numpy as jnp
from jax import lax
import numpy as np

D_MODEL = 4096
BATCH = 4
SEQ = 2048
DEPTH = 2

N_EVEN = (DEPTH + 1) // 2
N_ODD = DEPTH // 2
EPS = 1e-6
ROPE_THETA = 500000.0
HEAD_DIM = 128
ROT_DIM = HEAD_DIM // 4

S5_WIDTH = D_MODEL // 4
S5_GROUP = 16
S5_GROUPS = S5_WIDTH // S5_GROUP
S5_STATE = 64

DIL_PATTERNS = ((128, 1), (512, 4), (2048, 16))
N_DIL = len(DIL_PATTERNS)
DIL_HEADS = D_MODEL // 512
DIL_WIDTH = DIL_HEADS * HEAD_DIM

EVEN_IN = 2 * S5_WIDTH + 3 * N_DIL * DIL_WIDTH + DIL_WIDTH
EVEN_MIX = S5_WIDTH + DIL_WIDTH

MLA_HEADS = D_MODEL // HEAD_DIM
MLA_NOPE = HEAD_DIM - ROT_DIM
MLA_V = HEAD_DIM
Q_RANK = 1536
KV_RANK = 512
IDX_HEADS = D_MODEL // 128
IDX_DIM = 128
IDX_TOPK_MAX = 256
Q_BLOCK = 128
C_WIDTH = MLA_HEADS * MLA_V
ODD_IN = Q_RANK + KV_RANK + ROT_DIM + IDX_DIM + IDX_HEADS + C_WIDTH

kernel_name = 'hybrid_s5_dilated_dsa_trunk'


def rmsnorm(x, g):
    xf = x.astype(jnp.float32)
    y = xf * lax.rsqrt(jnp.mean(xf * xf, axis=-1, keepdims=True) + EPS)
    return (y * g.astype(jnp.float32)).astype(x.dtype)


def rope_tables(L):
    inv = ROPE_THETA ** (-jnp.arange(0, ROT_DIM, 2, dtype=jnp.float32) / ROT_DIM)
    ang = jnp.arange(L, dtype=jnp.float32)[:, None] * inv[None, :]
    return jnp.cos(ang), jnp.sin(ang)


def apply_rope(x, cos, sin):
    half = ROT_DIM // 2
    c = cos[None, :, None, :].astype(x.dtype)
    s = sin[None, :, None, :].astype(x.dtype)
    x1 = x[..., :half]
    x2 = x[..., half:ROT_DIM]
    return jnp.concatenate([x1 * c - x2 * s, x2 * c + x1 * s, x[..., ROT_DIM:]], axis=-1)


def _complex_affine_combine(e1, e2):
    a1r, a1i, b1r, b1i = e1
    a2r, a2i, b2r, b2i = e2
    ar = a2r * a1r - a2i * a1i
    ai = a2r * a1i + a2i * a1r
    br = a2r * b1r - a2i * b1i + b2r
    bi = a2r * b1i + a2i * b1r + b2i
    return ar, ai, br, bi


def s5_ssm(u, lam_re, lam_im, log_step, b_re, b_im, c_re, c_im, d_skip):
    bsz, L, _ = u.shape
    uf = u.astype(jnp.float32).reshape(bsz, L, S5_GROUPS, S5_GROUP)
    lr = jnp.minimum(lam_re.astype(jnp.float32), -1e-4)
    li = lam_im.astype(jnp.float32)
    dt = jnp.exp(log_step.astype(jnp.float32))[:, None]
    mag = jnp.exp(lr * dt)
    ar = mag * jnp.cos(li * dt)
    ai = mag * jnp.sin(li * dt)
    den = lr * lr + li * li
    nr, ni = ar - 1.0, ai
    cr = (nr * lr + ni * li) / den
    ci = (ni * lr - nr * li) / den
    br32, bi32 = b_re.astype(jnp.float32), b_im.astype(jnp.float32)
    bbr = cr[..., None] * br32 - ci[..., None] * bi32
    bbi = cr[..., None] * bi32 + ci[..., None] * br32
    bu_r = jnp.einsum('blgj,gpj->blgp', uf, bbr)
    bu_i = jnp.einsum('blgj,gpj->blgp', uf, bbi)
    a_r = jnp.broadcast_to(ar, bu_r.shape)
    a_i = jnp.broadcast_to(ai, bu_i.shape)
    _, _, s_r, s_i = lax.associative_scan(_complex_affine_combine, (a_r, a_i, bu_r, bu_i), axis=1)
    y = (jnp.einsum('gjp,blgp->blgj', c_re.astype(jnp.float32), s_r)
         - jnp.einsum('gjp,blgp->blgj', c_im.astype(jnp.float32), s_i))
    y = y.reshape(bsz, L, S5_WIDTH) + d_skip.astype(jnp.float32) * uf.reshape(bsz, L, S5_WIDTH)
    return y.astype(u.dtype)


def dilated_window_attention(q, k, v, dil, sub_window):
    bsz, L, H, D = q.shape
    n = L // dil
    qb = min(sub_window, n)
    nb = -(-n // qb)
    n_pad = nb * qb

    def to_sub(t):
        t = t.reshape(bsz, n, dil, H, D).transpose(0, 2, 3, 1, 4)
        return jnp.pad(t, ((0, 0), (0, 0), (0, 0), (0, n_pad - n), (0, 0)))

    def prev_cur(t):
        cur = t.reshape(bsz, dil, H, nb, qb, D)
        prev = jnp.pad(t, ((0, 0), (0, 0), (0, 0), (qb, 0), (0, 0)))[:, :, :, :n_pad]
        prev = prev.reshape(bsz, dil, H, nb, qb, D)
        return jnp.concatenate([prev, cur], axis=-2)

    qs = to_sub(q).reshape(bsz, dil, H, nb, qb, D)
    kb = prev_cur(to_sub(k))
    vb = prev_cur(to_sub(v))
    s = jnp.einsum('brhnqe,brhnke->brhnqk', qs, kb).astype(jnp.float32) * (HEAD_DIM ** -0.5)
    qi = jnp.arange(qb)[:, None]
    kj = jnp.arange(2 * qb)[None, :]
    dist = qi + qb - kj
    blk = jnp.arange(nb)[:, None, None]
    mask = (dist >= 0) & (dist <= sub_window) & ((blk > 0) | (kj >= qb))
    s = jnp.where(mask, s, -jnp.inf)
    lse = jax.nn.logsumexp(s, axis=-1)
    p = jnp.exp(s - lse[..., None]).astype(v.dtype)
    o = jnp.einsum('brhnqk,brhnke->brhnqe', p, vb)
    o = o.reshape(bsz, dil, H, n_pad, D)[:, :, :, :n]
    o = o.transpose(0, 3, 1, 2, 4).reshape(bsz, L, H, D)
    lse = lse.reshape(bsz, dil, H, n_pad)[..., :n].transpose(0, 3, 1, 2).reshape(bsz, L, H)
    return o, lse


def even_mixer(h, w_in, lam_re, lam_im, log_step, b_re, b_im, c_re, c_im, d_skip, glu_w, glu_b, w_out):
    bsz, L, _ = h.shape
    proj = h @ w_in
    u, z_a, qkv, z_b = jnp.split(
        proj, [S5_WIDTH, 2 * S5_WIDTH, 2 * S5_WIDTH + 3 * N_DIL * DIL_WIDTH], axis=-1)
    y = jax.nn.gelu(s5_ssm(u, lam_re, lam_im, log_step, b_re, b_im, c_re, c_im, d_skip))
    y = y * jax.nn.sigmoid(y @ glu_w + glu_b)
    a_out = y * jax.nn.silu(z_a)
    qkv = qkv.reshape(bsz, L, N_DIL, 3, DIL_HEADS, HEAD_DIM)
    cos, sin = rope_tables(L)
    outs, lses = [], []
    for g, (window, dil) in enumerate(DIL_PATTERNS):
        q = apply_rope(qkv[:, :, g, 0], cos, sin)
        k = apply_rope(qkv[:, :, g, 1], cos, sin)
        o, lse = dilated_window_attention(q, k, qkv[:, :, g, 2], dil, window // dil)
        outs.append(o)
        lses.append(lse)
    alpha = jax.nn.softmax(jnp.stack(lses, axis=0), axis=0).astype(h.dtype)
    o = jnp.sum(alpha[..., None] * jnp.stack(outs, axis=0), axis=0).reshape(bsz, L, DIL_WIDTH)
    b_out = o * jax.nn.silu(z_b)
    return jnp.concatenate([a_out, b_out], axis=-1) @ w_out


def odd_mixer(h, w_in, q_norm, kv_norm, k_idx_norm, w_uq, w_uk, w_uv, w_iq, w_out):
    bsz, L, _ = h.shape
    proj = h @ w_in
    c_q, c_kv, k_r, k_i, w_i, gate = jnp.split(
        proj, np.cumsum([Q_RANK, KV_RANK, ROT_DIM, IDX_DIM, IDX_HEADS]).tolist(), axis=-1)
    c_q = rmsnorm(c_q, q_norm)
    c_kv = rmsnorm(c_kv, kv_norm)
    cos, sin = rope_tables(L)
    q = apply_rope((c_q @ w_uq).reshape(bsz, L, MLA_HEADS, HEAD_DIM), cos, sin)
    q_rope, q_nope = q[..., :ROT_DIM], q[..., ROT_DIM:]
    k_rope = apply_rope(k_r[:, :, None, :], cos, sin)[:, :, 0]
    q_idx = apply_rope((c_q @ w_iq).reshape(bsz, L, IDX_HEADS, IDX_DIM), cos, sin)
    k_idx = apply_rope(rmsnorm(k_i, k_idx_norm)[:, :, None, :], cos, sin)[:, :, 0]
    topk = min(IDX_TOPK_MAX, L // 4)
    nb = L // Q_BLOCK
    kpos = jnp.arange(L)

    def to_blocks(t):
        return t.reshape(bsz, nb, Q_BLOCK, *t.shape[2:]).swapaxes(0, 1)

    def block_fn(args):
        start, qn, qr, qi, wi = args
        qpos = start + jnp.arange(Q_BLOCK)
        si = jnp.einsum('bqhd,bkd->bqhk', qi, k_idx).astype(jnp.float32) * (IDX_DIM ** -0.5)
        si = jnp.einsum('bqhk,bqh->bqk', jax.nn.relu(si),
                        wi.astype(jnp.float32) * (IDX_HEADS ** -0.5))
        si = jnp.where((kpos[None, :] <= qpos[:, None])[None], si, -jnp.inf)
        _, sel = lax.top_k(si, topk)
        valid = sel <= qpos[None, :, None]
        c_sel = jax.vmap(lambda c, i: c[i])(c_kv, sel)
        kr_sel = jax.vmap(lambda c, i: c[i])(k_rope, sel)
        q_lat = jnp.einsum('bqhd,chd->bqhc', qn, w_uk)
        s = (jnp.einsum('bqhc,bqkc->bqhk', q_lat, c_sel)
             + jnp.einsum('bqhr,bqkr->bqhk', qr, kr_sel)).astype(jnp.float32) * (HEAD_DIM ** -0.5)
        s = jnp.where(valid[:, :, None, :], s, -jnp.inf)
        p = jax.nn.softmax(s, axis=-1).astype(c_sel.dtype)
        o_lat = jnp.einsum('bqhk,bqkc->bqhc', p, c_sel)
        return jnp.einsum('bqhc,chd->bqhd', o_lat, w_uv)

    starts = jnp.arange(nb) * Q_BLOCK
    o = lax.map(block_fn, (starts, to_blocks(q_nope), to_blocks(q_rope), to_blocks(q_idx), to_blocks(w_i)))
    o = o.swapaxes(0, 1).reshape(bsz, L, C_WIDTH)
    return (o * jax.nn.silu(gate)) @ w_out


def setup_inputs(seed: int = 0) -> dict:
    key = jax.random.key(seed)
    ks = jax.random.split(key, 26)
    f32 = jnp.float32

    def nrm(k, shape, scale):
        return jax.random.normal(k, shape, f32) * scale

    lam_im_base = jnp.pi * jnp.arange(S5_STATE, dtype=f32)
    return {
        'x': nrm(ks[0], (BATCH, SEQ, D_MODEL), 1.0),
        'even_norm': 1.0 + nrm(ks[1], (N_EVEN, D_MODEL), 0.02),
        'even_w_in': nrm(ks[2], (N_EVEN, D_MODEL, EVEN_IN), D_MODEL ** -0.5),
        's5_lambda_re': -0.5 + nrm(ks[3], (N_EVEN, S5_GROUPS, S5_STATE), 0.01),
        's5_lambda_im': lam_im_base + nrm(ks[4], (N_EVEN, S5_GROUPS, S5_STATE), 0.01),
        's5_log_step': jax.random.uniform(ks[5], (N_EVEN, S5_GROUPS), f32, math.log(1e-3), math.log(1e-1)),
        's5_b_re': nrm(ks[6], (N_EVEN, S5_GROUPS, S5_STATE, S5_GROUP), (2 * S5_GROUP) ** -0.5),
        's5_b_im': nrm(ks[7], (N_EVEN, S5_GROUPS, S5_STATE, S5_GROUP), (2 * S5_GROUP) ** -0.5),
        's5_c_re': nrm(ks[8], (N_EVEN, S5_GROUPS, S5_GROUP, S5_STATE), 0.5),
        's5_c_im': nrm(ks[9], (N_EVEN, S5_GROUPS, S5_GROUP, S5_STATE), 0.5),
        's5_d': nrm(ks[10], (N_EVEN, S5_WIDTH), 1.0),
        's5_glu_w': nrm(ks[11], (N_EVEN, S5_WIDTH, S5_WIDTH), S5_WIDTH ** -0.5),
        's5_glu_b': nrm(ks[12], (N_EVEN, S5_WIDTH), 0.01),
        'even_w_out': nrm(ks[13], (N_EVEN, EVEN_MIX, D_MODEL), EVEN_MIX ** -0.5),
        'odd_norm': 1.0 + nrm(ks[14], (N_ODD, D_MODEL), 0.02),
        'odd_w_in': nrm(ks[15], (N_ODD, D_MODEL, ODD_IN), D_MODEL ** -0.5),
        'mla_q_norm': 1.0 + nrm(ks[16], (N_ODD, Q_RANK), 0.02),
        'mla_kv_norm': 1.0 + nrm(ks[17], (N_ODD, KV_RANK), 0.02),
        'idx_k_norm': 1.0 + nrm(ks[18], (N_ODD, IDX_DIM), 0.02),
        'mla_w_uq': nrm(ks[19], (N_ODD, Q_RANK, MLA_HEADS * HEAD_DIM), Q_RANK ** -0.5),
        'mla_w_uk': nrm(ks[20], (N_ODD, KV_RANK, MLA_HEADS, MLA_NOPE), KV_RANK ** -0.5),
        'mla_w_uv': nrm(ks[21], (N_ODD, KV_RANK, MLA_HEADS, MLA_V), KV_RANK ** -0.5),
        'idx_w_q': nrm(ks[22], (N_ODD, Q_RANK, IDX_HEADS * IDX_DIM), Q_RANK ** -0.5),
        'odd_w_out': nrm(ks[23], (N_ODD, C_WIDTH, D_MODEL), C_WIDTH ** -0.5),
        'final_norm': 1.0 + nrm(ks[24], (D_MODEL,), 0.02),
    }


def reference(x, even_norm, even_w_in, s5_lambda_re, s5_lambda_im, s5_log_step, s5_b_re, s5_b_im,
              s5_c_re, s5_c_im, s5_d, s5_glu_w, s5_glu_b, even_w_out, odd_norm, odd_w_in,
              mla_q_norm, mla_kv_norm, idx_k_norm, mla_w_uq, mla_w_uk, mla_w_uv, idx_w_q,
              odd_w_out, final_norm):
    for layer in range(DEPTH):
        i = layer // 2
        if layer % 2 == 0:
            h = rmsnorm(x, even_norm[i])
            x = x + even_mixer(h, even_w_in[i], s5_lambda_re[i], s5_lambda_im[i], s5_log_step[i],
                               s5_b_re[i], s5_b_im[i], s5_c_re[i], s5_c_im[i], s5_d[i],
                               s5_glu_w[i], s5_glu_b[i], even_w_out[i])
        else:
            h = rmsnorm(x, odd_norm[i])
            x = x + odd_mixer(h, odd_w_in[i], mla_q_norm[i], mla_kv_norm[i], idx_k_norm[i],
                              mla_w_uq[i], mla_w_uk[i], mla_w_uv[i], idx_w_q[i], odd_w_out[i])
    return rmsnorm(x, final_norm)
```

```cpp
#include <hip/hip_runtime.h>
#include <hip/hip_cooperative_groups.h>
#include <cstdio>
namespace cg = cooperative_groups;

#define LAS __attribute__((address_space(3)))
typedef unsigned short bf16_t;
typedef short bf16x8 __attribute__((ext_vector_type(8)));
typedef short s16x4 __attribute__((ext_vector_type(4)));
typedef float f32x4 __attribute__((ext_vector_type(4)));
typedef unsigned u32x4 __attribute__((ext_vector_type(4)));
typedef unsigned u32x2 __attribute__((ext_vector_type(2)));

constexpr int DM = 4096, BATCH = 4, SEQ = 2048, NTOK = BATCH * SEQ;
constexpr int EVEN_IN = 12288, ODD_IN = 6336, ODD_INP = 6400;
constexpr int QLD = 17408;
constexpr int KVLD = 544;
constexpr float EPS = 1e-6f;
constexpr float LOG2E = 1.4426950408889634f;
constexpr float ATT_SCALE = 0.08838834764831845f * LOG2E;

constexpr size_t SZ_WIN1 = (size_t)ODD_INP * 4096 * 2, SZ_WQ = (size_t)8192 * 1536 * 2, SZ_WUK = (size_t)32 * 512 * 128 * 2,
                 SZ_WUV = (size_t)16 * 256 * 1024 * 2, SZ_WOUT1 = (size_t)4096 * 4096 * 2;
constexpr size_t OFF_WIN1 = 0, OFF_WQ = OFF_WIN1 + SZ_WIN1, OFF_WUK = OFF_WQ + SZ_WQ, OFF_WUV = OFF_WUK + SZ_WUK, OFF_WOUT1 = OFF_WUV + SZ_WUV;
constexpr size_t OFF_ROPE = OFF_WOUT1 + SZ_WOUT1;
constexpr size_t OFF_SSQ = OFF_ROPE + 2048 * 16 * 8;
constexpr size_t OFF_RS1 = OFF_SSQ + (size_t)NTOK * 64 * 4;
constexpr size_t OFF_LSE = OFF_RS1 + NTOK * 4;
constexpr size_t OFF_B = OFF_LSE + (size_t)3 * NTOK * 8 * 4;
constexpr size_t OFF_A = OFF_B + (size_t)NTOK * 4096 * 2;
constexpr size_t OFF_PROJ1 = OFF_A, OFF_QBUF = OFF_PROJ1 + (size_t)NTOK * ODD_INP * 2, OFF_CKV = OFF_QBUF + (size_t)NTOK * 4096 * 2,
                 OFF_KIDX = OFF_CKV + (size_t)NTOK * KVLD * 2, OFF_WIDX = OFF_KIDX + (size_t)NTOK * 128 * 2, OFF_RSQ = OFF_WIDX + (size_t)NTOK * 32 * 4,
                 OFF_SEL = OFF_RSQ + NTOK * 4, OFF_A_END = OFF_SEL + (size_t)NTOK * 256 * 2;
constexpr size_t OFF_C = OFF_A + (size_t)NTOK * EVEN_IN * 2;
static_assert(OFF_A_END <= OFF_C, "region A overflow");
constexpr size_t OFF_YBUF = OFF_C, OFF_OBUF = OFF_YBUF + (size_t)NTOK * 1024 * 2, OFF_MIX = OFF_OBUF + (size_t)3 * NTOK * 1024 * 2, OFF_C_END = OFF_MIX + (size_t)NTOK * 2048 * 2;
constexpr size_t OFF_ISC = OFF_C;
static_assert((size_t)NTOK * 2048 * 4 <= OFF_C_END - OFF_C, "iscore");
constexpr size_t OFF_D = OFF_C_END;
constexpr size_t OFF_WIN0 = OFF_D, OFF_WGLU = OFF_WIN0 + (size_t)EVEN_IN * 4096 * 2, OFF_WOUT0 = OFF_WGLU + (size_t)1024 * 1024 * 2;
constexpr size_t OFF_BAR = OFF_D + (size_t)NTOK * QLD * 2;
constexpr size_t OFF_GP = OFF_BAR + 16384;
constexpr size_t OFF_END = OFF_GP + (size_t)2 * NTOK * 256 * 4;

constexpr int LDS_BYTES = 153600;

struct Params {
    const float *x, *even_norm, *even_w_in, *lam_re, *lam_im, *log_step, *b_re, *b_im, *c_re, *c_im, *s5_d, *glu_w, *glu_b, *even_w_out,
        *odd_norm, *odd_w_in, *q_norm, *kv_norm, *idx_k_norm, *w_uq, *w_uk, *w_uv, *w_iq, *odd_w_out, *final_norm;
    float* out; unsigned char* ws; int ph_lo, ph_hi, k128, rep, k2048, k512;
};

__device__ __forceinline__ unsigned cvt_pk_bf16(float lo, float hi) { unsigned r; asm volatile("v_cvt_pk_bf16_f32 %0, %1, %2" : "=v"(r) : "v"(lo), "v"(hi)); return r; }
__device__ __forceinline__ float bf2f(unsigned short b) { return __uint_as_float(((unsigned)b) << 16); }
__device__ __forceinline__ float bflo(unsigned u) { return __uint_as_float(u << 16); }
__device__ __forceinline__ float bfhi(unsigned u) { return __uint_as_float(u & 0xffff0000u); }
__device__ __forceinline__ u32x2 pack4(f32x4 v) { u32x2 r; r.x = cvt_pk_bf16(v.x, v.y); r.y = cvt_pk_bf16(v.z, v.w); return r; }
__device__ __forceinline__ f32x4 unpack4(u32x2 u) { f32x4 r; r.x = bflo(u.x); r.y = bfhi(u.x); r.z = bflo(u.y); r.w = bfhi(u.y); return r; }
__device__ __forceinline__ float silu_f(float z) { return z / (1.f + __expf(-z)); }
__device__ __forceinline__ float sigmoid_f(float z) { return 1.f / (1.f + __expf(-z)); }
typedef unsigned u32x2p_t __attribute__((ext_vector_type(2)));
__device__ __forceinline__ float xor32_val(float v, int lane) { const u32x2p_t r = __builtin_amdgcn_permlane32_swap(__float_as_uint(v), __float_as_uint(v), false, false); return __uint_as_float(lane < 32 ? r.y : r.x); }
__device__ __forceinline__ float sum_xor32(float v) { const u32x2p_t r = __builtin_amdgcn_permlane32_swap(__float_as_uint(v), __float_as_uint(v), false, false); return __uint_as_float(r.x) + __uint_as_float(r.y); }
__device__ __forceinline__ float sum_xor16(float v) { const u32x2p_t r = __builtin_amdgcn_permlane16_swap(__float_as_uint(v), __float_as_uint(v), false, false); return __uint_as_float(r.x) + __uint_as_float(r.y); }
__device__ __forceinline__ float max_xor32(float v) { const u32x2p_t r = __builtin_amdgcn_permlane32_swap(__float_as_uint(v), __float_as_uint(v), false, false); return fmaxf(__uint_as_float(r.x), __uint_as_float(r.y)); }
__device__ __forceinline__ float max_xor16(float v) { const u32x2p_t r = __builtin_amdgcn_permlane16_swap(__float_as_uint(v), __float_as_uint(v), false, false); return fmaxf(__uint_as_float(r.x), __uint_as_float(r.y)); }
__device__ __forceinline__ float wave_sum(float v) {
    v += __int_as_float(__builtin_amdgcn_update_dpp(0, __float_as_int(v), 0xB1, 0xf, 0xf, false));
    v += __int_as_float(__builtin_amdgcn_update_dpp(0, __float_as_int(v), 0x4E, 0xf, 0xf, false));
    v += __int_as_float(__builtin_amdgcn_update_dpp(0, __float_as_int(v), 0x141, 0xf, 0xf, false));
    v += __int_as_float(__builtin_amdgcn_update_dpp(0, __float_as_int(v), 0x140, 0xf, 0xf, false));
    return sum_xor32(sum_xor16(v));
}
__device__ __forceinline__ float row16_sum(float v) {
    v += __int_as_float(__builtin_amdgcn_update_dpp(0, __float_as_int(v), 0xB1, 0xf, 0xf, false));
    v += __int_as_float(__builtin_amdgcn_update_dpp(0, __float_as_int(v), 0x4E, 0xf, 0xf, false));
    v += __int_as_float(__builtin_amdgcn_update_dpp(0, __float_as_int(v), 0x141, 0xf, 0xf, false));
    v += __int_as_float(__builtin_amdgcn_update_dpp(0, __float_as_int(v), 0x140, 0xf, 0xf, false));
    return v;
}

constexpr int BM = 256, BK = 64, HALF = 128, HTB = HALF * BK * 2, NXCD = 8, WGM = 8;
__device__ __forceinline__ int lds_byte(int r, int c) { const int st = (r >> 4) * 2 + (c >> 5), rr = r & 15, cc = c & 31, ob = rr * 64 + cc * 2; return st * 1024 + (ob ^ (((ob >> 9) & 1) << 5)); }
__device__ __forceinline__ int perm32(int rho) { const int n = rho >> 4, i = rho & 15; return 8 * (i >> 2) + 4 * n + (i & 3); }
__device__ __forceinline__ void stage_rc(int b, int& R, int& C) { const int st = b / 1024, sb = b % 1024, swz = sb ^ (((sb >> 9) & 1) << 5); R = (st >> 1) * 16 + swz / 64; C = (st & 1) * 32 + (swz % 64) / 2; }

struct Unit { const char* a; const char* b; int pm, pn, z; };
template <class E, class = void> struct EpiAmap { static constexpr bool v = false; };
template <class E> struct EpiAmap<E, decltype((void)E::AMAP)> { static constexpr bool v = E::AMAP; };
template <class E, class = void> struct EpiPref { static constexpr bool v = false; };
template <class E> struct EpiPref<E, decltype((void)E::PREF)> { static constexpr bool v = E::PREF; };
template <class E, class = void> struct EpiDiag { static constexpr bool v = false; };
template <class E> struct EpiDiag<E, decltype((void)E::DIAG)> { static constexpr bool v = E::DIAG; };

__device__ __forceinline__ void swz_tile(int L, int nM, int nN, int& pm, int& pn) {
    const int nwg = nM * nN; int wgid = L;
    { const int q = nwg / NXCD, r = nwg % NXCD, xcd = wgid % NXCD, off = wgid / NXCD; wgid = (xcd < r ? xcd * (q + 1) : r * (q + 1) + (xcd - r) * q) + off; }
    const int nig = WGM * nN, gid = wgid / nig, fm = gid * WGM, gsz = (nM - fm) < WGM ? (nM - fm) : WGM;
    pm = fm + ((wgid % nig) % gsz); pn = (wgid % nig) / gsz;
}
__device__ __forceinline__ int xcd_run(int c, int G) { return (G & 7) ? c : (c & 7) * (G >> 3) + (c >> 3); }
struct Sched2D {
    const char* A; const char* B; size_t at, bt; int nM, nN, G, c;
    __device__ __forceinline__ bool next(int i, Unit& u) const {
        const long L = (long)i * G + c; if (c >= G || L >= (long)nM * nN) return false;
        swz_tile((int)L, nM, nN, u.pm, u.pn); u.z = 0; u.a = A + (size_t)u.pm * at; u.b = B + (size_t)u.pn * bt; return true; }
};

template <class Epi, class Sched>
__device__ __forceinline__ void gemm_phase(LAS unsigned char* lds, const int K, const int lda, const int ldb, const Sched& S, const Epi& E) {
    const int tid = threadIdx.x, wid = __builtin_amdgcn_readfirstlane(tid >> 6), lane = tid & 63, wr = wid >> 2, wc = wid & 3, fr = lane & 15, fq = lane >> 4;
    const int nt = K / BK;
    unsigned voffA[2], voffB[2];
#pragma unroll
    for (int i = 0; i < 2; ++i) { int R, C; stage_rc(tid * 16 + i * 8192, R, C); const int Rb = Epi::PERM ? ((R & ~31) + perm32(R & 31)) : R; const int Ra = EpiAmap<Epi>::v ? (((R >> 6) * 4 + ((R & 15) >> 2)) * 32 + (R & 3) * 8 + ((R >> 4) & 3)) : R; voffA[i] = (unsigned)(Ra * lda + C) * 2u; voffB[i] = (unsigned)(Rb * ldb + C) * 2u; }
    const size_t kstep = (size_t)(BK * 2);
    const size_t hstepA = EpiDiag<Epi>::v ? (size_t)512 * 2 : (EpiAmap<Epi>::v ? (size_t)4 * lda * 2 : (size_t)HALF * lda * 2), hstepB = (size_t)HALF * ldb * 2;
    const unsigned ldsw = (unsigned)wid * 1024u;
    const int aoff = lds_byte(wr * 64 + fr, fq * 8), boff = lds_byte(wc * 32 + fr, fq * 8);
#define PG8_SA(b, h) (((b) * 2 + (h)) * HTB)
#define PG8_SB(b, h) ((4 + (b) * 2 + (h)) * HTB)
#define PG8_STAGE(bufoff, gbase, voff) do { _Pragma("unroll") for (int _i = 0; _i < 2; ++_i) \
        __builtin_amdgcn_global_load_lds((const unsigned*)((const char*)(gbase) + (voff)[_i]), (LAS unsigned*)(lds + (bufoff) + ldsw + _i * 8192), 16, 0, 0); } while (0)
#define PG8_LDA(dst, b, h) do { _Pragma("unroll") for (int m = 0; m < 4; ++m) _Pragma("unroll") for (int k = 0; k < 2; ++k) dst[m][k] = *(const LAS bf16x8*)(lds + PG8_SA(b, h) + aoff + m * 2048 + k * 1024); } while (0)
#define PG8_LDB(dst, b, h) do { _Pragma("unroll") for (int n = 0; n < 2; ++n) _Pragma("unroll") for (int k = 0; k < 2; ++k) dst[n][k] = *(const LAS bf16x8*)(lds + PG8_SB(b, h) + boff + n * 2048 + k * 1024); } while (0)
#define PG8_MMA(ai, bj, At, Bt) do { __builtin_amdgcn_s_setprio(1); _Pragma("unroll") for (int m = 0; m < 4; ++m) _Pragma("unroll") for (int n = 0; n < 2; ++n) _Pragma("unroll") for (int k = 0; k < 2; ++k) \
        acc[ai][bj][m][n] = __builtin_amdgcn_mfma_f32_16x16x32_bf16(Bt[n][k], At[m][k], acc[ai][bj][m][n], 0, 0, 0); __builtin_amdgcn_s_setprio(0); } while (0)
#define PG8_MMA_OFF(ai, bj, At, Bt) do { if constexpr (!EpiDiag<Epi>::v) PG8_MMA(ai, bj, At, Bt); } while (0)
#define PG8_WAIT_V(n) asm volatile("s_waitcnt vmcnt(" #n ")" ::: "memory")
#define PG8_WAIT_L(n) asm volatile("s_waitcnt lgkmcnt(" #n ")" ::: "memory")
#define PG8_BAR __builtin_amdgcn_s_barrier()
#define PG8_SCHED __builtin_amdgcn_sched_barrier(0)
    Unit cur, nxt; int ui = 0;
    if (!S.next(0, cur)) return;
    f32x4 acc[2][2][4][2];
#pragma unroll
    for (int a = 0; a < 2; ++a)
#pragma unroll
        for (int b = 0; b < 2; ++b)
#pragma unroll
            for (int m = 0; m < 4; ++m)
#pragma unroll
                for (int n = 0; n < 2; ++n) acc[a][b][m][n] = (f32x4){0.f, 0.f, 0.f, 0.f};
    bf16x8 At[4][2], B0[2][2], B1[2][2];
    const char* cA = cur.a; const char* cB = cur.b;
    PG8_STAGE(PG8_SB(0, 0), cB, voffB); PG8_STAGE(PG8_SA(0, 0), cA, voffA); PG8_STAGE(PG8_SB(0, 1), cB + hstepB, voffB); PG8_STAGE(PG8_SA(0, 1), cA + hstepA, voffA);
    if (wr == 1) PG8_BAR;
    PG8_WAIT_V(4); PG8_BAR;
    PG8_STAGE(PG8_SB(1, 0), cB + kstep, voffB); PG8_STAGE(PG8_SA(1, 0), cA + kstep, voffA); PG8_STAGE(PG8_SB(1, 1), cB + hstepB + kstep, voffB);
    PG8_WAIT_V(6); PG8_BAR;
    for (;;) {
        const bool has_next = S.next(ui + 1, nxt);
        const char* nA = has_next ? nxt.a : cA; const char* nB = has_next ? nxt.b : cB;
        for (int t = 0; t < nt; t += 2) {
            const bool last = (t == nt - 2);
            const char* a1 = cA + (size_t)(t + 1) * kstep;
            const char* a2 = last ? nA : cA + (size_t)(t + 2) * kstep; const char* b2 = last ? nB : cB + (size_t)(t + 2) * kstep;
            const char* a3 = a2 + kstep; const char* b3 = b2 + kstep;
            PG8_LDB(B0, 0, 0); PG8_SCHED; PG8_LDA(At, 0, 0); PG8_STAGE(PG8_SA(1, 1), a1 + hstepA, voffA);
            PG8_WAIT_L(8); PG8_BAR; PG8_WAIT_L(0); PG8_MMA(0, 0, At, B0); PG8_BAR; PG8_SCHED;
            PG8_LDB(B1, 0, 1); PG8_STAGE(PG8_SB(0, 0), b2, voffB);
            PG8_BAR; PG8_WAIT_L(0); PG8_MMA_OFF(0, 1, At, B1); PG8_BAR;
            PG8_LDA(At, 0, 1); PG8_STAGE(PG8_SA(0, 0), a2, voffA);
            PG8_BAR; PG8_WAIT_L(0); PG8_MMA_OFF(1, 0, At, B0); PG8_BAR; PG8_SCHED;
            PG8_STAGE(PG8_SB(0, 1), b2 + hstepB, voffB);
            PG8_WAIT_V(6); PG8_BAR; PG8_MMA(1, 1, At, B1); PG8_BAR;
            PG8_LDB(B0, 1, 0); PG8_SCHED; PG8_LDA(At, 1, 0); PG8_STAGE(PG8_SA(0, 1), a2 + hstepA, voffA);
            PG8_WAIT_L(8); PG8_BAR; PG8_WAIT_L(0); PG8_MMA(0, 0, At, B0); PG8_BAR; PG8_SCHED;
            PG8_LDB(B1, 1, 1); PG8_STAGE(PG8_SB(1, 0), b3, voffB);
            PG8_BAR; PG8_WAIT_L(0); PG8_MMA_OFF(0, 1, At, B1); PG8_BAR;
            PG8_LDA(At, 1, 1); PG8_STAGE(PG8_SA(1, 0), a3, voffA);
            PG8_BAR; PG8_WAIT_L(0); PG8_MMA_OFF(1, 0, At, B0); PG8_BAR; PG8_SCHED;
            PG8_STAGE(PG8_SB(1, 1), b3 + hstepB, voffB);
            PG8_WAIT_V(6); PG8_BAR; PG8_MMA(1, 1, At, B1); PG8_BAR;
        }
        E(acc, cur, wr, wc, fr, fq);
        if (!has_next) break;
        if constexpr (EpiPref<Epi>::v) E.prefetch(nxt, wr, fr);
#pragma unroll
        for (int a = 0; a < 2; ++a)
#pragma unroll
            for (int b = 0; b < 2; ++b)
#pragma unroll
                for (int m = 0; m < 4; ++m)
#pragma unroll
                    for (int n = 0; n < 2; ++n) acc[a][b][m][n] = (f32x4){0.f, 0.f, 0.f, 0.f};
        cur = nxt; cA = nA; cB = nB; ++ui;
    }
    PG8_WAIT_V(0);
    if (wr == 0) PG8_BAR;
    PG8_BAR;
#undef PG8_SA
#undef PG8_SB
#undef PG8_STAGE
#undef PG8_LDA
#undef PG8_LDB
#undef PG8_MMA
#undef PG8_MMA_OFF
#undef PG8_WAIT_V
#undef PG8_WAIT_L
#undef PG8_BAR
#undef PG8_SCHED
}

typedef const f32x4 (&AccRef)[2][2][4][2];
#define EPI_ROWLOOP for (int ai = 0; ai < 2; ++ai) for (int m = 0; m < 4; ++m)
#define EPI_ROW(u) ((u).pm * BM + ai * HALF + wr * 64 + m * 16 + fr)
#define EPI_COL(u) ((u).pn * BM + bj * HALF + wc * 32 + n * 16 + 4 * fq)

#define EPI_COL8(u) ((u).pn * BM + bj * HALF + wc * 32 + 8 * fq)
__device__ __forceinline__ u32x4 pack8(f32x4 a, f32x4 b) { u32x4 r; r.x = cvt_pk_bf16(a.x, a.y); r.y = cvt_pk_bf16(a.z, a.w); r.z = cvt_pk_bf16(b.x, b.y); r.w = cvt_pk_bf16(b.z, b.w); return r; }
__device__ __forceinline__ void unpack8(u32x4 u, f32x4& a, f32x4& b) { a.x = bflo(u.x); a.y = bfhi(u.x); a.z = bflo(u.y); a.w = bfhi(u.y); b.x = bflo(u.z); b.y = bfhi(u.z); b.z = bflo(u.w); b.w = bfhi(u.w); }
struct RopeCS { float2 c[8]; };
__device__ __forceinline__ RopeCS rope_load(const float2* tab, int pos, int fq) { RopeCS r; const float2* t = tab + pos * 16 + 8 * (fq & 1);
#pragma unroll
    for (int e = 0; e < 8; ++e) r.c[e] = t[e];
    return r; }
__device__ __forceinline__ void rope_apply(f32x4& v0, f32x4& v1, const RopeCS& r, int fq) {
    const bool lo = fq < 2;
#pragma unroll
    for (int e = 0; e < 4; ++e) { const float o0 = xor32_val(v0[e], lo ? 0 : 32), o1 = xor32_val(v1[e], lo ? 0 : 32); const float2 c0 = r.c[e], c1 = r.c[4 + e];
        v0[e] = lo ? (v0[e] * c0.x - o0 * c0.y) : (v0[e] * c0.x + o0 * c0.y); v1[e] = lo ? (v1[e] * c1.x - o1 * c1.y) : (v1[e] * c1.x + o1 * c1.y); }
}
#define EPI_ROW_(u, ai, m) ((u).pm * BM + (ai) * HALF + wr * 64 + (m) * 16 + fr)

struct EpiProj0 {
    static constexpr bool PERM = true;
    bf16_t* out; const float2* rope;
    __device__ __forceinline__ void operator()(AccRef acc, const Unit& u, int wr, int wc, int fr, int fq) const {
        const int rel = u.pn * BM - 2048; const bool qk = rel >= 0 && rel < 9216 && (rel % 3072) < 2048; const bool isq = qk && (rel % 3072) < 1024;
        const float sc = isq ? ATT_SCALE : 1.f; const bool dorope = qk && wc == 0;
#pragma unroll
        for (int ai = 0; ai < 2; ++ai)
#pragma unroll
            for (int mh = 0; mh < 2; ++mh) { RopeCS cs[2];
                if (dorope) { cs[0] = rope_load(rope, EPI_ROW_(u, ai, 2 * mh) & 2047, fq); cs[1] = rope_load(rope, EPI_ROW_(u, ai, 2 * mh + 1) & 2047, fq); }
#pragma unroll
                for (int mm = 0; mm < 2; ++mm) { const int m = 2 * mh + mm, row = EPI_ROW_(u, ai, m);
#pragma unroll
                    for (int bj = 0; bj < 2; ++bj) { f32x4 v0 = acc[ai][bj][m][0], v1 = acc[ai][bj][m][1];
                        if (dorope) rope_apply(v0, v1, cs[mm], fq);
                        *(u32x4*)(out + (size_t)row * EVEN_IN + EPI_COL8(u)) = pack8(v0 * sc, v1 * sc); } } }
    }
};
struct EpiGlu {
    static constexpr bool PERM = true;
    const bf16_t* y; const bf16_t* proj0; const float* bias; bf16_t* mix;
    __device__ __forceinline__ void operator()(AccRef acc, const Unit& u, int wr, int wc, int fr, int fq) const {
        f32x4 bv[2][2];
#pragma unroll
        for (int bj = 0; bj < 2; ++bj) { const int col = EPI_COL8(u); bv[bj][0] = *(const f32x4*)(bias + col); bv[bj][1] = *(const f32x4*)(bias + col + 4); }
#pragma unroll
        for (int ai = 0; ai < 2; ++ai)
#pragma unroll
            for (int mh = 0; mh < 2; ++mh) { u32x4 yv[2][2], zv[2][2];
#pragma unroll
                for (int mm = 0; mm < 2; ++mm)
#pragma unroll
                    for (int bj = 0; bj < 2; ++bj) { const int row = EPI_ROW_(u, ai, 2 * mh + mm), col = EPI_COL8(u);
                        yv[mm][bj] = *(const u32x4*)(y + (size_t)row * 1024 + col); zv[mm][bj] = *(const u32x4*)(proj0 + (size_t)row * EVEN_IN + 1024 + col); }
#pragma unroll
                for (int mm = 0; mm < 2; ++mm)
#pragma unroll
                    for (int bj = 0; bj < 2; ++bj) { const int m = 2 * mh + mm, row = EPI_ROW_(u, ai, m), col = EPI_COL8(u); f32x4 y0, y1, z0, z1, r0, r1;
                        unpack8(yv[mm][bj], y0, y1); unpack8(zv[mm][bj], z0, z1);
#pragma unroll
                        for (int e = 0; e < 4; ++e) { r0[e] = y0[e] * sigmoid_f(acc[ai][bj][m][0][e] + bv[bj][0][e]) * silu_f(z0[e]); r1[e] = y1[e] * sigmoid_f(acc[ai][bj][m][1][e] + bv[bj][1][e]) * silu_f(z1[e]); }
                        *(u32x4*)(mix + (size_t)row * 2048 + col) = pack8(r0, r1); } }
    }
};
struct EpiResid {
    static constexpr bool PERM = true;
    const float* xin; float* xo; bf16_t* xb; float* ssq;
    __device__ __forceinline__ void operator()(AccRef acc, const Unit& u, int wr, int wc, int fr, int fq) const {
#pragma unroll
        for (int ai = 0; ai < 2; ++ai)
#pragma unroll
            for (int mh = 0; mh < 2; ++mh) { f32x4 xv[2][2][2];
#pragma unroll
                for (int mm = 0; mm < 2; ++mm)
#pragma unroll
                    for (int bj = 0; bj < 2; ++bj) { const size_t o = (size_t)EPI_ROW_(u, ai, 2 * mh + mm) * DM + EPI_COL8(u); xv[mm][bj][0] = *(const f32x4*)(xin + o); xv[mm][bj][1] = *(const f32x4*)(xin + o + 4); }
#pragma unroll
                for (int mm = 0; mm < 2; ++mm) { const int m = 2 * mh + mm, row = EPI_ROW_(u, ai, m); float ss = 0.f;
#pragma unroll
                    for (int bj = 0; bj < 2; ++bj) { const size_t o = (size_t)row * DM + EPI_COL8(u);
                        const f32x4 v0 = xv[mm][bj][0] + acc[ai][bj][m][0], v1 = xv[mm][bj][1] + acc[ai][bj][m][1];
                        *(f32x4*)(xo + o) = v0; *(f32x4*)(xo + o + 4) = v1;
                        if (xb) *(u32x4*)(xb + o) = pack8(v0, v1);
                        ss += v0.x * v0.x + v0.y * v0.y + v0.z * v0.z + v0.w * v0.w + v1.x * v1.x + v1.y * v1.y + v1.z * v1.z + v1.w * v1.w; }
                    ss = sum_xor16(ss); ss = sum_xor32(ss);
                    if (fq == 0) ssq[(size_t)row * 64 + u.pn * 4 + wc] = ss; } }
    }
};
struct EpiProj1 {
    static constexpr bool PERM = true;
    bf16_t* out; const float* rs;
    __device__ __forceinline__ void operator()(AccRef acc, const Unit& u, int wr, int wc, int fr, int fq) const {
        float rsv[2][4];
#pragma unroll
        EPI_ROWLOOP rsv[ai][m] = rs[EPI_ROW(u)];
#pragma unroll
        EPI_ROWLOOP { const int row = EPI_ROW(u); const float s = rsv[ai][m];
#pragma unroll
            for (int bj = 0; bj < 2; ++bj) *(u32x4*)(out + (size_t)row * ODD_INP + EPI_COL8(u)) = pack8(acc[ai][bj][m][0] * s, acc[ai][bj][m][1] * s); }
    }
};
struct EpiQ {
    static constexpr bool PERM = true;
    bf16_t* qbuf; bf16_t* qidx; const float* rs; const float2* rope;
    __device__ __forceinline__ void operator()(AccRef acc, const Unit& u, int wr, int wc, int fr, int fq) const {
        bf16_t* base = u.pn < 16 ? qbuf : qidx; const int colt = (u.pn & 15) * BM;
        float rsv[2][4];
#pragma unroll
        EPI_ROWLOOP rsv[ai][m] = rs[EPI_ROW(u)];
#pragma unroll
        for (int ai = 0; ai < 2; ++ai)
#pragma unroll
            for (int mh = 0; mh < 2; ++mh) { RopeCS cs[2];
                if (wc == 0) { cs[0] = rope_load(rope, EPI_ROW_(u, ai, 2 * mh) & 2047, fq); cs[1] = rope_load(rope, EPI_ROW_(u, ai, 2 * mh + 1) & 2047, fq); }
#pragma unroll
                for (int mm = 0; mm < 2; ++mm) { const int m = 2 * mh + mm, row = EPI_ROW_(u, ai, m); const float s = rsv[ai][m];
#pragma unroll
                    for (int bj = 0; bj < 2; ++bj) { f32x4 v0 = acc[ai][bj][m][0] * s, v1 = acc[ai][bj][m][1] * s;
                        if (wc == 0) rope_apply(v0, v1, cs[mm], fq);
                        *(u32x4*)(base + (size_t)row * 4096 + colt + bj * HALF + wc * 32 + 8 * fq) = pack8(v0, v1); } } }
    }
};
struct EpiQlat {
    static constexpr bool PERM = true;
    bf16_t* qlat; const bf16_t* qbuf;
    __device__ __forceinline__ void operator()(AccRef acc, const Unit& u, int wr, int wc, int fr, int fq) const {
        const bool rp = u.pn == 0 && wc == 0; u32x4 rv[2][4];
        if (rp) {
#pragma unroll
            EPI_ROWLOOP rv[ai][m] = *(const u32x4*)(qbuf + (size_t)EPI_ROW(u) * 4096 + u.z * 128 + 8 * fq); }
#pragma unroll
        EPI_ROWLOOP { const int row = EPI_ROW(u); bf16_t* o = qlat + (size_t)row * QLD + u.z * 544;
#pragma unroll
            for (int bj = 0; bj < 2; ++bj) *(u32x4*)(o + EPI_COL8(u)) = pack8(acc[ai][bj][m][0], acc[ai][bj][m][1]);
            if (rp) { f32x4 v0, v1; unpack8(rv[ai][m], v0, v1); *(u32x4*)(o + 512 + 8 * fq) = pack8(v0 * ATT_SCALE, v1 * ATT_SCALE); } }
    }
};
struct EpiIdx {       static constexpr bool PERM = false, AMAP = true, PREF = true;
    float* isc; const float* widx; mutable f32x4 pwa, pwb; mutable int ptok;
    __device__ __forceinline__ void prefetch(const Unit& n, int wr, int fr) const { const int t = n.pm * 8 + wr * 4 + (fr >> 2); ptok = t; pwa = *(const f32x4*)(widx + t * 32 + (fr & 3) * 8); pwb = *(const f32x4*)(widx + t * 32 + (fr & 3) * 8 + 4); }
    __device__ __forceinline__ void operator()(AccRef acc, const Unit& u, int wr, int wc, int fr, int fq) const {
        const int token = u.pm * 8 + wr * 4 + (fr >> 2);
        f32x4 wa = pwa, wb = pwb;
        if (ptok != token) { wa = *(const f32x4*)(widx + token * 32 + (fr & 3) * 8); wb = *(const f32x4*)(widx + token * 32 + (fr & 3) * 8 + 4); }
        float* orow = isc + (size_t)token * 2048 + u.pn * BM + wc * 32 + 4 * fq;
#pragma unroll
        for (int bj = 0; bj < 2; ++bj)
#pragma unroll
            for (int n = 0; n < 2; ++n) { f32x4 r;
#pragma unroll
                for (int e = 0; e < 4; ++e) { float v = 0.f;
#pragma unroll
                    for (int m = 0; m < 4; ++m) { v += wa[m] * fmaxf(acc[0][bj][m][n][e], 0.f); v += wb[m] * fmaxf(acc[1][bj][m][n][e], 0.f); }
                    v += __int_as_float(__builtin_amdgcn_update_dpp(0, __float_as_int(v), 0xB1, 0xf, 0xf, false));
                    v += __int_as_float(__builtin_amdgcn_update_dpp(0, __float_as_int(v), 0x4E, 0xf, 0xf, false));
                    r[e] = v; }
                if ((fr & 3) == 0) *(f32x4*)(orow + bj * HALF + n * 16) = r; }
    }
};
struct EpiOV {
    static constexpr bool PERM = true;
    bf16_t* og; const bf16_t* proj1; const float* gp;
    __device__ __forceinline__ void operator()(AccRef acc, const Unit& u, int wr, int wc, int fr, int fq) const {
        if (u.pn != 15) {
#pragma unroll
            for (int ai = 0; ai < 2; ++ai) { u32x4 gv[4][2];
#pragma unroll
                for (int m = 0; m < 4; ++m)
#pragma unroll
                    for (int bj = 0; bj < 2; ++bj) gv[m][bj] = *(const u32x4*)(proj1 + (size_t)EPI_ROW_(u, ai, m) * ODD_INP + 2240 + EPI_COL8(u));
#pragma unroll
                for (int m = 0; m < 4; ++m)
#pragma unroll
                    for (int bj = 0; bj < 2; ++bj) { f32x4 g0, g1, r0, r1; unpack8(gv[m][bj], g0, g1);
#pragma unroll
                        for (int e = 0; e < 4; ++e) { r0[e] = acc[ai][bj][m][0][e] * silu_f(g0[e]); r1[e] = acc[ai][bj][m][1][e] * silu_f(g1[e]); }
                        *(u32x4*)(og + (size_t)EPI_ROW_(u, ai, m) * 4096 + EPI_COL8(u)) = pack8(r0, r1); } }
        } else {
#pragma unroll
        EPI_ROWLOOP { const int row = EPI_ROW(u);
#pragma unroll
            for (int bj = 0; bj < 2; ++bj) { const int col = EPI_COL8(u); f32x4 g0, g1;
                if (col >= 3904) { const float* g = gp + (size_t)row * 256 + (col - 3904); g0 = *(const f32x4*)g + *(const f32x4*)(g + (size_t)NTOK * 256); g1 = *(const f32x4*)(g + 4) + *(const f32x4*)(g + (size_t)NTOK * 256 + 4); }
                else unpack8(*(const u32x4*)(proj1 + (size_t)row * ODD_INP + 2240 + col), g0, g1);
                f32x4 r0, r1;
#pragma unroll
                for (int e = 0; e < 4; ++e) { r0[e] = acc[ai][bj][m][0][e] * silu_f(g0[e]); r1[e] = acc[ai][bj][m][1][e] * silu_f(g1[e]); }
                *(u32x4*)(og + (size_t)row * 4096 + col) = pack8(r0, r1); } }
        }
    }
};

struct EpiOVd {
    static constexpr bool PERM = true, DIAG = true;
    bf16_t* og; const bf16_t* proj1; const float* gp;
    __device__ __forceinline__ void operator()(AccRef acc, const Unit& u, int wr, int wc, int fr, int fq) const {
#pragma unroll
        for (int ai = 0; ai < 2; ++ai) { const int col = u.pn * 256 + ai * 128 + wc * 32 + 8 * fq; f32x4 g0[4], g1[4];
#pragma unroll
            for (int m = 0; m < 4; ++m) { const int row = u.pm * 128 + wr * 64 + m * 16 + fr;
                if (col >= 3904) { const float* g = gp + (size_t)row * 256 + (col - 3904); g0[m] = *(const f32x4*)g + *(const f32x4*)(g + (size_t)NTOK * 256); g1[m] = *(const f32x4*)(g + 4) + *(const f32x4*)(g + (size_t)NTOK * 256 + 4); }
                else unpack8(*(const u32x4*)(proj1 + (size_t)row * ODD_INP + 2240 + col), g0[m], g1[m]); }
#pragma unroll
            for (int m = 0; m < 4; ++m) { const int row = u.pm * 128 + wr * 64 + m * 16 + fr; f32x4 r0, r1;
#pragma unroll
                for (int e = 0; e < 4; ++e) { r0[e] = acc[ai][ai][m][0][e] * silu_f(g0[m][e]); r1[e] = acc[ai][ai][m][1][e] * silu_f(g1[m][e]); }
                *(u32x4*)(og + (size_t)row * 4096 + col) = pack8(r0, r1); } }
    }
};
struct SchedOVd {
    const char* olat; const char* wuv; int G, c;
    __device__ __forceinline__ bool next(int i, Unit& u) const {
        const int L = i * G + xcd_run(c, G); if (L >= 1024) return false;
        u.pn = L >> 6; u.pm = L & 63; u.z = 0;
        u.a = olat + ((size_t)u.pm * 128 * QLD + u.pn * 1024) * 2; u.b = wuv + (size_t)u.pn * 256 * 512 * 2; return true; }
};
struct EpiGatePart {
    static constexpr bool PERM = true;
    float* gp; const float* rs;
    __device__ __forceinline__ void operator()(AccRef acc, const Unit& u, int wr, int wc, int fr, int fq) const {
        float rsv[2][4];
#pragma unroll
        EPI_ROWLOOP rsv[ai][m] = rs[EPI_ROW(u)];
#pragma unroll
        EPI_ROWLOOP { const int row = EPI_ROW(u); const float s = rsv[ai][m]; float* o = gp + ((size_t)u.z * NTOK + row) * 256 + wc * 32 + 8 * fq;
#pragma unroll
            for (int bj = 0; bj < 2; ++bj) { *(f32x4*)(o + bj * HALF) = acc[ai][bj][m][0] * s; *(f32x4*)(o + bj * HALF + 4) = acc[ai][bj][m][1] * s; } }
    }
};
struct SchedGateSplit {
    const char* A; const char* B; int c;
    __device__ __forceinline__ bool next(int i, Unit& u) const {
        if (i > 0 || c >= 64) return false;
        u.pm = c >> 1; u.z = c & 1; u.pn = 0;
        u.a = A + ((size_t)u.pm * 256 * 4096 + u.z * 2048) * 2; u.b = B + ((size_t)24 * 256 * 4096 + u.z * 2048) * 2; return true; }
};
struct SchedQlat {
    const char* qbuf; const char* wuk; int G, c;
    __device__ __forceinline__ bool next(int i, Unit& u) const {
        const int L = i * G + xcd_run(c, G); if (L >= 2048) return false;
        u.z = L >> 6; u.pm = (L & 63) >> 1; u.pn = L & 1;
        u.a = qbuf + ((size_t)u.pm * 256 * 4096 + u.z * 128) * 2; u.b = wuk + ((size_t)u.z * 512 + u.pn * 256) * 128 * 2; return true; }
};
struct SchedIdx {
    const char* qidx; const char* kidx; int G, c;
    __device__ __forceinline__ bool next(int i, Unit& u) const {
        const int L = i * G + xcd_run(c, G); if (L >= 4 * 1120) return false;
        const int b = L / 1120, r = L % 1120 + 32; int j = 0;
#pragma unroll
        for (int t = 1; t < 8; ++t) if (r >= 16 * t * (t + 1)) j = t;
        const int rr = r - 16 * j * (j + 1), pml = 32 * j + rr / (j + 1); u.pn = rr % (j + 1); u.pm = b * 256 + pml; u.z = b;
        u.a = qidx + (size_t)u.pm * 8 * 4096 * 2; u.b = kidx + ((size_t)b * 2048 + u.pn * 256) * 128 * 2; return true; }
};
struct SchedOV {
    const char* olat; const char* wuv; int G, c;
    __device__ __forceinline__ bool next(int i, Unit& u) const {
        const int L = i * G + c; if (L >= 512) return false;
        u.pn = L >> 5; u.pm = L & 31; u.z = 0;
        u.a = olat + ((size_t)u.pm * 256 * QLD + u.pn * 1024) * 2; u.b = wuv + (size_t)u.pn * 256 * 1024 * 2; return true; }
};

struct ConvJob { const float* src; const float* gain; bf16_t* dst; int N, kt, nt, ldd, mode; };
struct ConvRegs { f32x4 v[2]; float g[2]; };
__device__ __forceinline__ void conv_load(const ConvJob& j, ConvRegs& r) {
    const int tid = threadIdx.x;
#pragma unroll
    for (int i = 0; i < 2; ++i) { const int row = (tid >> 4) + 32 * i, c4 = (tid & 15) * 4;
        r.v[i] = *(const f32x4*)(j.src + (size_t)(j.kt * 64 + row) * j.N + j.nt * 64 + c4); r.g[i] = j.gain ? j.gain[j.kt * 64 + row] : 1.f; }
}
#define CONV_BAR() do { asm volatile("s_waitcnt lgkmcnt(0)" ::: "memory"); __builtin_amdgcn_s_barrier(); asm volatile("" ::: "memory"); } while (0)
__device__ __forceinline__ void conv_store(LAS float* tile, const ConvJob& j, const ConvRegs& r) {
    const int tid = threadIdx.x, k0 = j.kt * 64, n0 = j.nt * 64;
    CONV_BAR();
#pragma unroll
    for (int i = 0; i < 2; ++i) { const int row = (tid >> 4) + 32 * i, c4 = (tid & 15) * 4; const f32x4 v = r.v[i] * r.g[i];
        LAS float* t = tile + row * 65 + c4; t[0] = v.x; t[1] = v.y; t[2] = v.z; t[3] = v.w; }
    CONV_BAR();
    const int n = tid >> 3, kc = (tid & 7) * 8; float f[8];
#pragma unroll
    for (int q = 0; q < 8; ++q) f[q] = tile[(kc + q) * 65 + n];
    u32x4 o; o.x = cvt_pk_bf16(f[0], f[1]); o.y = cvt_pk_bf16(f[2], f[3]); o.z = cvt_pk_bf16(f[4], f[5]); o.w = cvt_pk_bf16(f[6], f[7]);
    const int gn = n0 + n, gk = k0 + kc;
    if (j.mode == 0) *(u32x4*)(j.dst + (size_t)gn * j.ldd + gk) = o;
    else { const int h = gn >> 7, dv = gn & 127; bf16_t* rr = j.dst + ((size_t)(h >> 1) * 256 + (h & 1) * 128 + dv) * 1024;
        *(u32x4*)(rr + (h & 1) * 512 + gk) = o; *(u32x4*)(rr + ((h & 1) ^ 1) * 512 + gk) = (u32x4){0u, 0u, 0u, 0u}; }
}
__device__ __forceinline__ ConvJob conv_job_a(const Params& p, int t) {
    constexpr int T0 = 64 * 192, T1 = T0 + 16 * 16, T2 = T1 + 32 * 64; unsigned char* ws = p.ws; ConvJob j;
    if (t < T0)      { j = ConvJob{p.even_w_in, nullptr, (bf16_t*)(ws + OFF_WIN0), 12288, t / 192, t % 192, 4096, 0}; }
    else if (t < T1) { const int l = t - T0; j = ConvJob{p.glu_w, nullptr, (bf16_t*)(ws + OFF_WGLU), 1024, l / 16, l % 16, 1024, 0}; }
    else if (t < T2) { const int l = t - T1; j = ConvJob{p.even_w_out, nullptr, (bf16_t*)(ws + OFF_WOUT0), 4096, l / 64, l % 64, 2048, 0}; }
    else             { const int l = t - T2; j = ConvJob{p.odd_w_in, p.odd_norm, (bf16_t*)(ws + OFF_WIN1), ODD_IN, l / 99, l % 99, 4096, 0}; }
    return j;
}
__device__ __forceinline__ ConvJob conv_job_b(const Params& p, int t) {
    constexpr int T4 = 24 * 64, T5 = T4 + 24 * 64, T6 = T5 + 8 * 64; unsigned char* ws = p.ws; ConvJob j;
    if (t < T4)      { j = ConvJob{p.w_uq, p.q_norm, (bf16_t*)(ws + OFF_WQ), 4096, t / 64, t % 64, 1536, 0}; }
    else if (t < T5) { const int l = t - T4; j = ConvJob{p.w_iq, p.q_norm, (bf16_t*)(ws + OFF_WQ) + (size_t)4096 * 1536, 4096, l / 64, l % 64, 1536, 0}; }
    else if (t < T6) { const int l = t - T5; j = ConvJob{p.w_uv, nullptr, (bf16_t*)(ws + OFF_WUV), 4096, l / 64, l % 64, 512, 0}; }
    else             { const int l = t - T6; j = ConvJob{p.odd_w_out, nullptr, (bf16_t*)(ws + OFF_WOUT1), 4096, l / 64, l % 64, 4096, 0}; }
    return j;
}
template <bool PARTB>
__device__ __forceinline__ void conv_run(LAS unsigned char* lds, const Params& p, int first, int stride, int total) {
    if (first >= total) return;
    LAS float* tile = (LAS float*)lds;
    ConvJob cur = PARTB ? conv_job_b(p, first) : conv_job_a(p, first); ConvRegs rc; conv_load(cur, rc);
#pragma nounroll
    for (int t = first; t < total; t += stride) {
        const bool has_next = t + stride < total; const ConvJob nxt = PARTB ? conv_job_b(p, has_next ? t + stride : t) : conv_job_a(p, has_next ? t + stride : t);
        ConvRegs rn; if (has_next) conv_load(nxt, rn); else rn = rc;
        conv_store(tile, cur, rc);
        cur = nxt; rc = rn;
    }
}

__device__ __forceinline__ void phase0(LAS unsigned char* lds, const Params& p) {
    unsigned char* ws = p.ws; const int G = gridDim.x, bid = blockIdx.x, tid = threadIdx.x, lane = tid & 63, wid = tid >> 6;
    { bf16_t* h0 = (bf16_t*)(ws + OFF_B);
      for (int row = bid * 8 + wid; row < NTOK; row += G * 8) { const float* xr = p.x + (size_t)row * DM; f32x4 v[16]; float ss = 0.f;
#pragma unroll
          for (int i = 0; i < 16; ++i) { v[i] = *(const f32x4*)(xr + (i * 64 + lane) * 4); ss += v[i].x * v[i].x + v[i].y * v[i].y + v[i].z * v[i].z + v[i].w * v[i].w; }
          ss = wave_sum(ss); const float rs = rsqrtf(ss * (1.f / DM) + EPS);
#pragma unroll
          for (int i = 0; i < 16; ++i) { const f32x4 g = *(const f32x4*)(p.even_norm + (i * 64 + lane) * 4); *(u32x2*)(h0 + (size_t)row * DM + (i * 64 + lane) * 4) = pack4(v[i] * rs * g); } } }
    { float2* tab = (float2*)(ws + OFF_ROPE);
      for (int i = bid * 512 + tid; i < 2048 * 16; i += G * 512) { const int pos = i >> 4, j = i & 15; const float inv = powf(500000.f, -(float)(2 * j) / 32.f); const float ang = (float)pos * inv; tab[i] = make_float2(cosf(ang), sinf(ang)); } }
    { u32x4* d = (u32x4*)(ws + OFF_WIN1 + (size_t)ODD_IN * 4096 * 2);
      for (int i = bid * 512 + tid; i < 64 * 4096 * 2 / 16; i += G * 512) d[i] = (u32x4){0u, 0u, 0u, 0u}; }
    conv_run<false>(lds, p, bid, G, 64 * 192 + 16 * 16 + 32 * 64 + 64 * 99);
}

__device__ __forceinline__ void phase0b(LAS unsigned char* lds, const Params& p, int rank, int n) {
    unsigned char* ws = p.ws; const int tid = threadIdx.x;
    { bf16_t* d = (bf16_t*)(ws + OFF_WUK);
      for (int i = rank * 512 + tid; i < 32 * 512 * 16; i += n * 512) { const int kc = i & 15, c = (i >> 4) & 511, h = i >> 13; u32x4 o = (u32x4){0u, 0u, 0u, 0u};
          if (kc >= 4) { const float* sp = p.w_uk + ((size_t)c * 32 + h) * 96 + (kc - 4) * 8; const f32x4 a = *(const f32x4*)sp * ATT_SCALE, b = *(const f32x4*)(sp + 4) * ATT_SCALE;
              o.x = cvt_pk_bf16(a.x, a.y); o.y = cvt_pk_bf16(a.z, a.w); o.z = cvt_pk_bf16(b.x, b.y); o.w = cvt_pk_bf16(b.z, b.w); }
          *(u32x4*)(d + ((size_t)h * 512 + c) * 128 + kc * 8) = o; } }
    conv_run<true>(lds, p, rank, n, 24 * 64 + 24 * 64 + 8 * 64 + 64 * 64);
}

__device__ __forceinline__ void s5_item(LAS unsigned char* lds, const Params& p, int item) {
    const int b = item >> 6, g = item & 63, tid = threadIdx.x, lane = tid & 63, wid = tid >> 6, l15 = lane & 15, q4 = lane >> 4;
    const bf16_t* proj0 = (const bf16_t*)(p.ws + OFF_A); bf16_t* ybuf = (bf16_t*)(p.ws + OFF_YBUF);
    LAS unsigned char* u_s = lds;
    LAS unsigned char* W_s = lds + 65536 + wid * 8448;
    LAS float* carry = (LAS float*)(lds + 65536 + 8 * 8448);
    LAS float* cst = carry + 1024;
    __syncthreads();
    for (int i = tid; i < 4096; i += 512) { const int t = i >> 1, hf = i & 1; *(LAS u32x4*)(u_s + t * 32 + hf * 16) = *(const u32x4*)(proj0 + (size_t)(b * SEQ + t) * EVEN_IN + g * 16 + hf * 8); }
    const int gp = g * 64 + lane;
    const float lr = fminf(p.lam_re[gp], -1e-4f), li = p.lam_im[gp], dt = expf(p.log_step[g]);
    const float mag = expf(lr * dt), ar = mag * cosf(li * dt), ai = mag * sinf(li * dt);
    { const float den = lr * lr + li * li, nr = ar - 1.f, ni = ai;
      if (wid == 0) { cst[lane * 4] = ar; cst[lane * 4 + 1] = ai; cst[lane * 4 + 2] = (nr * lr + ni * li) / den; cst[lane * 4 + 3] = (ni * lr - nr * li) / den; } }
    bf16x8 cf[4];
#pragma unroll
    for (int kb = 0; kb < 4; ++kb) { const float* sp = (kb < 2 ? p.c_re : p.c_im) + ((size_t)g * 16 + l15) * 64 + (kb & 1) * 32 + 8 * q4; const float sg = kb < 2 ? 1.f : -1.f;
        const f32x4 a = *(const f32x4*)sp * sg, c = *(const f32x4*)(sp + 4) * sg; u32x4 o; o.x = cvt_pk_bf16(a.x, a.y); o.y = cvt_pk_bf16(a.z, a.w); o.z = cvt_pk_bf16(c.x, c.y); o.w = cvt_pk_bf16(c.z, c.w);
        cf[kb] = __builtin_bit_cast(bf16x8, o); }
    const float dsk = p.s5_d[g * 16 + l15];
    __syncthreads();
    bf16x8 bre[4], bim[4];
#pragma unroll
    for (int pt = 0; pt < 4; ++pt) { const int ps = 16 * pt + l15; const float cr = cst[ps * 4 + 2], ci = cst[ps * 4 + 3];
        const float* br = p.b_re + ((size_t)g * 64 + ps) * 16 + (q4 & 1) * 8; const float* bi = p.b_im + ((size_t)g * 64 + ps) * 16 + (q4 & 1) * 8;
        const f32x4 r0 = *(const f32x4*)br, r1 = *(const f32x4*)(br + 4), i0 = *(const f32x4*)bi, i1 = *(const f32x4*)(bi + 4);
        float vr[8], vi[8];
#pragma unroll
        for (int e = 0; e < 4; ++e) { vr[e] = cr * r0[e] - ci * i0[e]; vi[e] = cr * i0[e] + ci * r0[e]; vr[4 + e] = cr * r1[e] - ci * i1[e]; vi[4 + e] = cr * i1[e] + ci * r1[e]; }
        if (q4 >= 2) {
#pragma unroll
            for (int e = 0; e < 8; ++e) { vr[e] -= bf2f((bf16_t)(cvt_pk_bf16(vr[e], 0.f) & 0xffffu)); vi[e] -= bf2f((bf16_t)(cvt_pk_bf16(vi[e], 0.f) & 0xffffu)); } }
        u32x4 o; o.x = cvt_pk_bf16(vr[0], vr[1]); o.y = cvt_pk_bf16(vr[2], vr[3]); o.z = cvt_pk_bf16(vr[4], vr[5]); o.w = cvt_pk_bf16(vr[6], vr[7]); bre[pt] = __builtin_bit_cast(bf16x8, o);
        o.x = cvt_pk_bf16(vi[0], vi[1]); o.y = cvt_pk_bf16(vi[2], vi[3]); o.z = cvt_pk_bf16(vi[4], vi[5]); o.w = cvt_pk_bf16(vi[6], vi[7]); bim[pt] = __builtin_bit_cast(bf16x8, o); }
    const int t0 = wid * 256;
#define S5_BU(tb) { const bf16x8 ua = *(const LAS bf16x8*)(u_s + ((tb) + l15) * 32 + (q4 & 1) * 16); \
        _Pragma("unroll") for (int pt = 0; pt < 4; ++pt) { const f32x4 z4 = (f32x4){0.f, 0.f, 0.f, 0.f}; \
            const f32x4 dr = __builtin_amdgcn_mfma_f32_16x16x32_bf16(ua, bre[pt], z4, 0, 0, 0), di = __builtin_amdgcn_mfma_f32_16x16x32_bf16(ua, bim[pt], z4, 0, 0, 0); \
            _Pragma("unroll") for (int i = 0; i < 4; ++i) { *(LAS float*)(W_s + (4 * q4 + i) * 528 + (16 * pt + l15) * 4) = dr[i]; *(LAS float*)(W_s + (4 * q4 + i) * 528 + 256 + (16 * pt + l15) * 4) = di[i]; } } \
        __builtin_amdgcn_wave_barrier(); }
    float sr = 0.f, si = 0.f;
    for (int sc = 0; sc < 16; ++sc) { S5_BU(t0 + sc * 16)
#pragma unroll
        for (int tt = 0; tt < 16; ++tt) { const float br_ = *(const LAS float*)(W_s + tt * 528 + lane * 4), bi_ = *(const LAS float*)(W_s + tt * 528 + 256 + lane * 4);
            const float nsr = ar * sr - ai * si + br_, nsi = ar * si + ai * sr + bi_; sr = nsr; si = nsi; }
        __builtin_amdgcn_wave_barrier(); }
    carry[(wid * 64 + lane) * 2] = sr; carry[(wid * 64 + lane) * 2 + 1] = si;
    __syncthreads();
    float pr = ar, pi = ai;
#pragma unroll
    for (int i = 0; i < 8; ++i) { const float nr2 = pr * pr - pi * pi, ni2 = 2.f * pr * pi; pr = nr2; pi = ni2; }
    sr = 0.f; si = 0.f;
    for (int v = 0; v < wid; ++v) { const float er = carry[(v * 64 + lane) * 2], ei = carry[(v * 64 + lane) * 2 + 1]; const float nsr = pr * sr - pi * si + er, nsi = pr * si + pi * sr + ei; sr = nsr; si = nsi; }
    for (int sc = 0; sc < 16; ++sc) { S5_BU(t0 + sc * 16)
#pragma unroll
        for (int tt = 0; tt < 16; ++tt) { const float br_ = *(const LAS float*)(W_s + tt * 528 + lane * 4), bi_ = *(const LAS float*)(W_s + tt * 528 + 256 + lane * 4);
            const float nsr = ar * sr - ai * si + br_, nsi = ar * si + ai * sr + bi_; sr = nsr; si = nsi;
            const unsigned pk = cvt_pk_bf16(sr, si);
            *(LAS bf16_t*)(W_s + tt * 528 + lane * 2) = (bf16_t)(pk & 0xffffu); *(LAS bf16_t*)(W_s + tt * 528 + 128 + lane * 2) = (bf16_t)(pk >> 16); }
        __builtin_amdgcn_wave_barrier();
        f32x4 acc = (f32x4){0.f, 0.f, 0.f, 0.f};
#pragma unroll
        for (int kb = 0; kb < 4; ++kb) { const bf16x8 a = *(const LAS bf16x8*)(W_s + l15 * 528 + kb * 64 + q4 * 16); acc = __builtin_amdgcn_mfma_f32_16x16x32_bf16(a, cf[kb], acc, 0, 0, 0); }
        __builtin_amdgcn_wave_barrier();
#pragma unroll
        for (int i = 0; i < 4; ++i) { const int t = t0 + sc * 16 + 4 * q4 + i; const float uv = bf2f(*(const LAS bf16_t*)(u_s + t * 32 + l15 * 2));
            const float yv = acc[i] + dsk * uv; const float z = 0.7978845608028654f * (yv + 0.044715f * yv * yv * yv); const float th = 1.f - 2.f / (__expf(2.f * z) + 1.f);
            const float gl = 0.5f * yv * (1.f + th);
            ybuf[(size_t)(b * SEQ + t) * 1024 + g * 16 + l15] = (bf16_t)(cvt_pk_bf16(gl, 0.f) & 0xffffu); }
    }
#undef S5_BU
}

__device__ __forceinline__ void dil_item(LAS unsigned char* lds, const Params& p, int item) {
    const int tid = threadIdx.x, lane = tid & 63, w = __builtin_amdgcn_readfirstlane(tid >> 6), l15 = lane & 15, q4 = lane >> 4;
    const int bh = item / 48, r48 = item % 48, b = bh >> 3, h = bh & 7, g = r48 >> 4, j = r48 & 15;
    const int dil = g == 0 ? 1 : (g == 1 ? 4 : 16), cls = j % dil, blk = j / dil, q0 = blk * 128;
    const bf16_t* proj0 = (const bf16_t*)(p.ws + OFF_A);
    const int qcol = 2048 + g * 3072 + h * 128, kcol = qcol + 1024, vcol = qcol + 2048;
    LAS unsigned char* Ks = lds; LAS unsigned char* Vs = lds + 128 * 288;
    const int qi = q0 + 16 * w + l15;
    bf16x8 qf[4];
    { const bf16_t* qp = proj0 + (size_t)(b * SEQ + cls + dil * qi) * EVEN_IN + qcol + 8 * q4;
#pragma unroll
      for (int ks = 0; ks < 4; ++ks) qf[ks] = *(const bf16x8*)(qp + 32 * ks); }
    float mrun = -INFINITY, lsum = 0.f; f32x4 O[8];
#pragma unroll
    for (int d = 0; d < 8; ++d) O[d] = (f32x4){0.f, 0.f, 0.f, 0.f};
    for (int half = (blk == 0 ? 1 : 0); half < 2; ++half) {
        const int kbase = q0 - 128 + 128 * half;
        __syncthreads();
#pragma unroll
        for (int i = 0; i < 4; ++i) { const int pc = tid + 512 * i, row = pc >> 4, ch = pc & 15; const bf16_t* src = proj0 + (size_t)(b * SEQ + cls + dil * (kbase + row)) * EVEN_IN + ch * 8;
            *(LAS u32x4*)(Ks + row * 288 + ch * 16) = *(const u32x4*)(src + kcol); *(LAS u32x4*)(Vs + row * 288 + ch * 16) = *(const u32x4*)(src + vcol); }
        __syncthreads();
        f32x4 S[8]; float mx = -INFINITY;
#pragma unroll
        for (int kt = 0; kt < 8; ++kt) { f32x4 a = (f32x4){-INFINITY, -INFINITY, -INFINITY, -INFINITY};
            if (half ? (kt <= w) : (kt >= w)) { a = (f32x4){0.f, 0.f, 0.f, 0.f};
#pragma unroll
                for (int ks = 0; ks < 4; ++ks) { const bf16x8 kf = *(const LAS bf16x8*)(Ks + (16 * kt + l15) * 288 + ks * 64 + q4 * 16); a = __builtin_amdgcn_mfma_f32_16x16x32_bf16(kf, qf[ks], a, 0, 0, 0); }
#pragma unroll
                for (int i = 0; i < 4; ++i) { const int dist = qi - (kbase + 16 * kt + 4 * q4 + i); a[i] = (dist >= 0 && dist <= 128) ? a[i] : -INFINITY; mx = fmaxf(mx, a[i]); } }
            S[kt] = a; }
        mx = max_xor32(max_xor16(mx));
        const float mnew = fmaxf(mrun, mx), alpha = exp2f(mrun - mnew); mrun = mnew; lsum *= alpha;
#pragma unroll
        for (int d = 0; d < 8; ++d) O[d] = O[d] * alpha;
#pragma unroll
        for (int kt = 0; kt < 8; ++kt)
#pragma unroll
            for (int i = 0; i < 4; ++i) { const float pv = exp2f(S[kt][i] - mnew); S[kt][i] = pv; lsum += pv; }
#pragma unroll
        for (int s = 0; s < 4; ++s) if (half ? (2 * s <= w) : (2 * s + 1 >= w)) { u32x4 pk; pk.x = cvt_pk_bf16(S[2 * s][0], S[2 * s][1]); pk.y = cvt_pk_bf16(S[2 * s][2], S[2 * s][3]); pk.z = cvt_pk_bf16(S[2 * s + 1][0], S[2 * s + 1][1]); pk.w = cvt_pk_bf16(S[2 * s + 1][2], S[2 * s + 1][3]);
            const bf16x8 pf = __builtin_bit_cast(bf16x8, pk);
#pragma unroll
            for (int d = 0; d < 8; ++d) {
                LAS unsigned char* va = Vs + (32 * s + 4 * q4 + (l15 >> 2)) * 288 + (16 * d + 4 * (l15 & 3)) * 2;
                const s16x4 t0 = __builtin_amdgcn_ds_read_tr16_b64_v4i16((LAS s16x4*)va), t1 = __builtin_amdgcn_ds_read_tr16_b64_v4i16((LAS s16x4*)(va + 16 * 288));
                const bf16x8 vf = __builtin_shufflevector(t0, t1, 0, 1, 2, 3, 4, 5, 6, 7);
                O[d] = __builtin_amdgcn_mfma_f32_16x16x32_bf16(vf, pf, O[d], 0, 0, 0); } }
    }
    lsum = sum_xor32(sum_xor16(lsum));
    const float inv = 1.f / lsum; const size_t tok = (size_t)b * SEQ + cls + dil * qi;
    bf16_t* ob = (bf16_t*)(p.ws + OFF_OBUF) + ((size_t)g * NTOK + tok) * 1024 + h * 128 + 4 * q4;
#pragma unroll
    for (int d = 0; d < 8; ++d) *(u32x2*)(ob + 16 * d) = pack4(O[d] * inv);
    if (q4 == 0) ((float*)(p.ws + OFF_LSE))[((size_t)g * NTOK + tok) * 8 + h] = mrun + log2f(lsum);
}

__device__ __forceinline__ void merge_rows(const Params& p, int first, int stride) {
    const bf16_t* __restrict__ obuf = (const bf16_t*)(p.ws + OFF_OBUF); const float* __restrict__ lse = (const float*)(p.ws + OFF_LSE); const bf16_t* __restrict__ proj0 = (const bf16_t*)(p.ws + OFF_A); bf16_t* __restrict__ mix = (bf16_t*)(p.ws + OFF_MIX);
    const int c = threadIdx.x, h = c >> 6;
    for (int tok0 = first; tok0 < NTOK; tok0 += 4 * stride) {
        float l[4][3]; unsigned o[4][3], zb[4];
#pragma unroll
        for (int u = 0; u < 4; ++u) { const int tok = tok0 + u * stride; if (tok < NTOK) {
#pragma unroll
            for (int g = 0; g < 3; ++g) { l[u][g] = lse[((size_t)g * NTOK + tok) * 8 + h]; o[u][g] = *(const unsigned*)(obuf + ((size_t)g * NTOK + tok) * 1024 + 2 * c); }
            zb[u] = *(const unsigned*)(proj0 + (size_t)tok * EVEN_IN + 11264 + 2 * c); } }
#pragma unroll
        for (int u = 0; u < 4; ++u) { const int tok = tok0 + u * stride; if (tok < NTOK) {
            const float mx = fmaxf(l[u][0], fmaxf(l[u][1], l[u][2])), e0 = exp2f(l[u][0] - mx), e1 = exp2f(l[u][1] - mx), e2 = exp2f(l[u][2] - mx), inv = 1.f / (e0 + e1 + e2);
            const float a = (e0 * bflo(o[u][0]) + e1 * bflo(o[u][1]) + e2 * bflo(o[u][2])) * inv * silu_f(bflo(zb[u])), bq = (e0 * bfhi(o[u][0]) + e1 * bfhi(o[u][1]) + e2 * bfhi(o[u][2])) * inv * silu_f(bfhi(zb[u]));
            *(unsigned*)(mix + (size_t)tok * 2048 + 1024 + 2 * c) = cvt_pk_bf16(a, bq); } }
    }
}

__device__ __forceinline__ void phase7(LAS unsigned char* lds, const Params& p) {
    const int lane = threadIdx.x & 63, wid = threadIdx.x >> 6;
    const bf16_t* proj1 = (const bf16_t*)(p.ws + OFF_PROJ1); bf16_t* ckv = (bf16_t*)(p.ws + OFF_CKV); bf16_t* kidx = (bf16_t*)(p.ws + OFF_KIDX);
    float* widx = (float*)(p.ws + OFF_WIDX); float* rsq = (float*)(p.ws + OFF_RSQ); const float2* rope = (const float2*)(p.ws + OFF_ROPE);
    float kmaxw = 0.f;
    for (int row = blockIdx.x * 8 + wid; row < NTOK; row += gridDim.x * 8) { const bf16_t* pr = proj1 + (size_t)row * ODD_INP; const int pos = row & 2047;
        float ss = 0.f, kn2 = 0.f;
#pragma unroll
        for (int i = 0; i < 3; ++i) { const u32x4 v = *(const u32x4*)(pr + (i * 64 + lane) * 8);
            ss += bflo(v.x) * bflo(v.x) + bfhi(v.x) * bfhi(v.x) + bflo(v.y) * bflo(v.y) + bfhi(v.y) * bfhi(v.y) + bflo(v.z) * bflo(v.z) + bfhi(v.z) * bfhi(v.z) + bflo(v.w) * bflo(v.w) + bfhi(v.w) * bfhi(v.w); }
        ss = wave_sum(ss); if (lane == 0) rsq[row] = rsqrtf(ss * (1.f / 1536.f) + EPS);
        { const u32x4 v = *(const u32x4*)(pr + 1536 + lane * 8); float f[8] = {bflo(v.x), bfhi(v.x), bflo(v.y), bfhi(v.y), bflo(v.z), bfhi(v.z), bflo(v.w), bfhi(v.w)}; float s2 = 0.f;
#pragma unroll
          for (int e = 0; e < 8; ++e) s2 += f[e] * f[e];
          s2 = wave_sum(s2); const float r = rsqrtf(s2 * (1.f / 512.f) + EPS); const f32x4 g0 = *(const f32x4*)(p.kv_norm + lane * 8), g1 = *(const f32x4*)(p.kv_norm + lane * 8 + 4);
          u32x4 o; o.x = cvt_pk_bf16(f[0] * r * g0.x, f[1] * r * g0.y); o.y = cvt_pk_bf16(f[2] * r * g0.z, f[3] * r * g0.w); o.z = cvt_pk_bf16(f[4] * r * g1.x, f[5] * r * g1.y); o.w = cvt_pk_bf16(f[6] * r * g1.z, f[7] * r * g1.w);
          *(u32x4*)(ckv + (size_t)row * KVLD + lane * 8) = o;
          float k2 = 0.f;
#pragma unroll
          for (int e = 0; e < 4; ++e) { const float a0 = f[e] * r * g0[e], a1 = f[4 + e] * r * g1[e]; k2 += a0 * a0 + a1 * a1; }
          kn2 = k2; }
        {
          const float v = bf2f(pr[2048 + (lane & 31)]); const float o = __shfl_xor(v, 16); const float2 cs = rope[pos * 16 + (lane & 15)];
          const float r = (lane & 16) ? (v * cs.x + o * cs.y) : (v * cs.x - o * cs.y);
          if (lane < 32) { ckv[(size_t)row * KVLD + 512 + lane] = (bf16_t)(cvt_pk_bf16(r, 0.f) & 0xffffu); kn2 += r * r; }
          kn2 = wave_sum(kn2); kmaxw = fmaxf(kmaxw, kn2); }
        {
          const float a = bf2f(pr[2080 + lane]), c = bf2f(pr[2080 + 64 + lane]); const float s2 = wave_sum(a * a + c * c); const float r = rsqrtf(s2 * (1.f / 128.f) + EPS);
          float an = a * r * p.idx_k_norm[lane]; const float cn = c * r * p.idx_k_norm[64 + lane];
          const float o = __shfl_xor(an, 16); const float2 cs = rope[pos * 16 + (lane & 15)];
          if (lane < 32) an = (lane & 16) ? (an * cs.x + o * cs.y) : (an * cs.x - o * cs.y);
          kidx[(size_t)row * 128 + lane] = (bf16_t)(cvt_pk_bf16(an, 0.f) & 0xffffu); kidx[(size_t)row * 128 + 64 + lane] = (bf16_t)(cvt_pk_bf16(cn, 0.f) & 0xffffu); }
        if (lane < 32) widx[(size_t)row * 32 + lane] = bf2f(pr[2208 + lane]) * (0.08838834764831845f * 0.17677669529663687f);
    }
    LAS float* red = (LAS float*)lds;
    __syncthreads();
    if (lane == 0) red[wid] = kmaxw;
    __syncthreads();
    if (threadIdx.x == 0) { float m = red[0];
#pragma unroll
        for (int i = 1; i < 8; ++i) m = fmaxf(m, red[i]);
        atomicMax((int*)(p.ws + OFF_BAR), __float_as_int(m * 1.02f)); }
}

__device__ __forceinline__ unsigned fkey(float f) { const unsigned u = __float_as_uint(f); return (u & 0x80000000u) ? ~u : (u | 0x80000000u); }
__device__ __forceinline__ void topk_pair(const Params& p, int tokA, int tokB) {
    const int lane = threadIdx.x & 63; const bool two = tokB >= 0; if (!two) tokB = tokA;
    const int qp[2] = {tokA & 2047, tokB & 2047};
    const float* sc[2] = {(const float*)(p.ws + OFF_ISC) + (size_t)tokA * 2048, (const float*)(p.ws + OFF_ISC) + (size_t)tokB * 2048};
    bf16_t* sel[2] = {(bf16_t*)(p.ws + OFF_SEL) + (size_t)tokA * 256, (bf16_t*)(p.ws + OFF_SEL) + (size_t)tokB * 256};
    unsigned key[2][32];
#pragma unroll
    for (int q = 0; q < 2; ++q)
#pragma unroll
        for (int i = 0; i < 32; ++i) { const int idx = i * 64 + lane; key[q][i] = idx <= qp[q] ? fkey(sc[q][idx <= qp[q] ? idx : 0]) : 0u; }
    unsigned T[2] = {0u, 0u}; bool ex[2] = {false, false};
    for (int bit = 31; bit >= 0; --bit) {
        if (ex[0] && ex[1]) break;
        const unsigned c0 = T[0] | (1u << bit), c1 = T[1] | (1u << bit); unsigned cnt = 0u;
#pragma unroll
        for (int i = 0; i < 32; ++i) { cnt += (key[0][i] >= c0) ? 1u : 0u; cnt += (key[1][i] >= c1) ? 0x10000u : 0u; }
        cnt += (unsigned)__builtin_amdgcn_update_dpp(0, (int)cnt, 0xB1, 0xf, 0xf, false);
        cnt += (unsigned)__builtin_amdgcn_update_dpp(0, (int)cnt, 0x4E, 0xf, 0xf, false);
        cnt += (unsigned)__builtin_amdgcn_update_dpp(0, (int)cnt, 0x141, 0xf, 0xf, false);
        cnt += (unsigned)__builtin_amdgcn_update_dpp(0, (int)cnt, 0x140, 0xf, 0xf, false);
        { typedef unsigned u32x2p __attribute__((ext_vector_type(2)));
          u32x2p r = __builtin_amdgcn_permlane16_swap(cnt, cnt, false, false); cnt = r.x + r.y;
          r = __builtin_amdgcn_permlane32_swap(cnt, cnt, false, false); cnt = r.x + r.y; }
        cnt = (unsigned)__builtin_amdgcn_readfirstlane((int)cnt);
        const int n0 = (int)(cnt & 0xffffu), n1 = (int)(cnt >> 16);
        if (!ex[0]) { if (n0 >= 256) T[0] = c0; if (n0 == 256) ex[0] = true; }
        if (!ex[1]) { if (n1 >= 256) T[1] = c1; if (n1 == 256) ex[1] = true; }
    }
#pragma unroll
    for (int q = 0; q < 2; ++q) { if (q == 1 && !two) break;
        int base = 0;
#pragma unroll
        for (int i = 0; i < 32; ++i) { const bool pr = ex[q] ? key[q][i] >= T[q] : key[q][i] > T[q]; const unsigned long long mk = __ballot(pr); const int pos = base + __builtin_amdgcn_mbcnt_hi((unsigned)(mk >> 32), __builtin_amdgcn_mbcnt_lo((unsigned)mk, 0u));
            if (pr) sel[q][pos] = (bf16_t)(i * 64 + lane); base += __popcll(mk); }
        if (!ex[q])
#pragma unroll
        for (int i = 0; i < 32; ++i) { const bool pr = key[q][i] == T[q]; const unsigned long long mk = __ballot(pr); const int pos = base + __builtin_amdgcn_mbcnt_hi((unsigned)(mk >> 32), __builtin_amdgcn_mbcnt_lo((unsigned)mk, 0u));
            if (pr && pos < 256) sel[q][pos] = (bf16_t)(i * 64 + lane); base += __popcll(mk); } }
}
__device__ __forceinline__ void topk_phase(const Params& p) {
    const int lane = threadIdx.x & 63, wid = threadIdx.x >> 6, G = gridDim.x, bid = blockIdx.x;
    const int nq = (NTOK - bid + G - 1) / G;
    int mine[4]; int nm = 0;
    int k = 0;
    for (int j = 0; j < nq; ++j) { const int token = bid + G * j, qpos = token & 2047;
        if (qpos < 256) { if ((j & 7) == wid) { bf16_t* sel = (bf16_t*)(p.ws + OFF_SEL) + (size_t)token * 256; for (int i = lane; i <= qpos; i += 64) sel[i] = (bf16_t)i; } }
        else { if ((k & 7) == wid && nm < 4) { if (nm == 0) mine[0] = token; else if (nm == 1) mine[1] = token; else if (nm == 2) mine[2] = token; else mine[3] = token; ++nm; } else if ((k & 7) == wid) topk_pair(p, token, -1); ++k; } }
    if (nm >= 2) topk_pair(p, mine[0], mine[1]); else if (nm == 1) topk_pair(p, mine[0], -1);
    if (nm >= 4) topk_pair(p, mine[2], mine[3]); else if (nm == 3) topk_pair(p, mine[2], -1);
}


#define LDSRD4(k0, k1, k2, k3, addr, o0, o1, o2, o3) asm volatile("ds_read_b128 %0, %4 offset:%5\n\tds_read_b128 %1, %4 offset:%6\n\tds_read_b128 %2, %4 offset:%7\n\tds_read_b128 %3, %4 offset:%8\n\ts_waitcnt lgkmcnt(0)" \
        : "=&v"(k0), "=&v"(k1), "=&v"(k2), "=&v"(k3) : "v"(addr), "n"(o0), "n"(o1), "n"(o2), "n"(o3) : "memory")
#define LDSRD2(k0, k1, addr, o0, o1) asm volatile("ds_read_b128 %0, %2 offset:%3\n\tds_read_b128 %1, %2 offset:%4\n\ts_waitcnt lgkmcnt(0)" : "=&v"(k0), "=&v"(k1) : "v"(addr), "n"(o0), "n"(o1) : "memory")
#define LDSRD1(k0, addr, o0) asm volatile("ds_read_b128 %0, %1 offset:%2\n\ts_waitcnt lgkmcnt(0)" : "=&v"(k0) : "v"(addr), "n"(o0) : "memory")
__device__ __forceinline__ void lds_rd_mx8(float (&m)[8], unsigned addr) {
    asm volatile("ds_read_b32 %0, %8\n\tds_read_b32 %1, %8 offset:128\n\tds_read_b32 %2, %8 offset:256\n\tds_read_b32 %3, %8 offset:384\n\t"
                 "ds_read_b32 %4, %8 offset:64\n\tds_read_b32 %5, %8 offset:192\n\tds_read_b32 %6, %8 offset:320\n\tds_read_b32 %7, %8 offset:448\n\ts_waitcnt lgkmcnt(0)"
                 : "=&v"(m[0]), "=&v"(m[1]), "=&v"(m[2]), "=&v"(m[3]), "=&v"(m[4]), "=&v"(m[5]), "=&v"(m[6]), "=&v"(m[7]) : "v"(addr) : "memory");
}
#define LDSRD_PV(p0, p1, t, pb, vb, PO, VO) asm volatile("ds_read_b128 %0, %10 offset:%12\n\tds_read_b128 %1, %10 offset:%13\n\t" \
        "ds_read_b64_tr_b16 %2, %11 offset:%14\n\tds_read_b64_tr_b16 %3, %11 offset:%15\n\tds_read_b64_tr_b16 %4, %11 offset:%16\n\tds_read_b64_tr_b16 %5, %11 offset:%17\n\t" \
        "ds_read_b64_tr_b16 %6, %11 offset:%18\n\tds_read_b64_tr_b16 %7, %11 offset:%19\n\tds_read_b64_tr_b16 %8, %11 offset:%20\n\tds_read_b64_tr_b16 %9, %11 offset:%21\n\ts_waitcnt lgkmcnt(0)" \
        : "=&v"(p0), "=&v"(p1), "=&v"(t[0]), "=&v"(t[1]), "=&v"(t[2]), "=&v"(t[3]), "=&v"(t[4]), "=&v"(t[5]), "=&v"(t[6]), "=&v"(t[7]) \
        : "v"(pb), "v"(vb), "n"(PO), "n"((PO) + 2304), "n"(VO), "n"((VO) + 4416), "n"((VO) + 32), "n"((VO) + 32 + 4416), "n"((VO) + 64), "n"((VO) + 64 + 4416), "n"((VO) + 96), "n"((VO) + 96 + 4416) : "memory")
#define LDSRD_PVA(p0, p1, t, pb, vb, PO, VO) asm volatile("ds_read_b128 %0, %6 offset:%8\n\tds_read_b128 %1, %6 offset:%9\n\t" \
        "ds_read_b64_tr_b16 %2, %7 offset:%10\n\tds_read_b64_tr_b16 %3, %7 offset:%11\n\tds_read_b64_tr_b16 %4, %7 offset:%12\n\tds_read_b64_tr_b16 %5, %7 offset:%13\n\ts_waitcnt lgkmcnt(0)" \
        : "=&v"(p0), "=&v"(p1), "=&v"(t[0]), "=&v"(t[1]), "=&v"(t[2]), "=&v"(t[3]) \
        : "v"(pb), "v"(vb), "n"(PO), "n"((PO) + 2304), "n"(VO), "n"((VO) + 4416), "n"((VO) + 32), "n"((VO) + 32 + 4416) : "memory")
#define LDSRD_PVB(t, vb, VO) asm volatile("ds_read_b64_tr_b16 %0, %4 offset:%5\n\tds_read_b64_tr_b16 %1, %4 offset:%6\n\tds_read_b64_tr_b16 %2, %4 offset:%7\n\tds_read_b64_tr_b16 %3, %4 offset:%8\n\ts_waitcnt lgkmcnt(0)" \
        : "=&v"(t[0]), "=&v"(t[1]), "=&v"(t[2]), "=&v"(t[3]) : "v"(vb), "n"((VO) + 64), "n"((VO) + 64 + 4416), "n"((VO) + 96), "n"((VO) + 96 + 4416) : "memory")
#define WG_BAR() do { asm volatile("s_waitcnt lgkmcnt(0)" ::: "memory"); __builtin_amdgcn_s_barrier(); asm volatile("" ::: "memory"); } while (0)
__device__ __forceinline__ void dsa_phase(LAS unsigned char* lds, const Params& p, bool do_write) {
    const int tid = threadIdx.x, lane = tid & 63, w = tid >> 6, l15 = lane & 15, q4 = lane >> 4, kt = w & 3, ht = w >> 2;
    const int G = gridDim.x, bid = blockIdx.x;
    const int nq = (NTOK - bid + G - 1) / G;
    if (nq <= 0) return;
    LAS unsigned char* Pl = lds + 141312;
    LAS float* mxs = (LAS float*)(lds + 145920);
    LAS float* lred = mxs + 128;
    LAS int* sels = (LAS int*)(lds + 146944);
    const bf16_t* selg = (const bf16_t*)(p.ws + OFF_SEL);
    const float kmax2 = __int_as_float(__hip_atomic_load((const int*)(p.ws + OFF_BAR), __ATOMIC_RELAXED, __HIP_MEMORY_SCOPE_AGENT));
    unsigned gpk[5] = {0u, 0u, 0u, 0u, 0u};
#pragma unroll
    for (int i = 0; i < 9; ++i) { const int q = w + 8 * i, pc = 64 * q + lane, row = q < 69 ? pc / 69 : 0, col = pc - row * 69; gpk[i >> 1] |= ((unsigned)row | ((unsigned)col << 6)) << (16 * (i & 1)); }
#define GATHER_DMA(ckvb, selbase, buf) { _Pragma("unroll") for (int i = 0; i < 9; ++i) { const int q = w + 8 * i; if (q < 69) { unsigned gw = gpk[i >> 1]; asm volatile("" : "+v"(gw)); const unsigned ge = (gw >> (16 * (i & 1))) & 0xffffu; const int col = (int)(ge >> 6); \
        const int idx = sels[(selbase) + (int)(ge & 63u)]; const unsigned char* gsrc = (ckvb) + (size_t)idx * (KVLD * 2) + (col < 68 ? col * 16 : 0); \
        __builtin_amdgcn_global_load_lds((const unsigned*)gsrc, (LAS unsigned*)((buf) + q * 1024), 16, 0, 0); } } }
#define DMA_WAIT() asm volatile("s_waitcnt vmcnt(0)" ::: "memory")
    const unsigned sa0 = (unsigned)(size_t)(lds + (16 * kt + l15) * 1104 + q4 * 16);
    const unsigned va0 = (unsigned)(size_t)(lds + (8 * q4 + (l15 >> 2)) * 1104 + (64 * w + 4 * (l15 & 3)) * 2);
    const unsigned pa0 = (unsigned)(size_t)(Pl + l15 * 144 + q4 * 16);
    const unsigned ma0 = (unsigned)(size_t)((LAS unsigned char*)mxs + l15 * 4);
    bf16x8 qf[17];
    { const int token = bid, qpos = token & 2047, cnt = qpos + 1 < 256 ? qpos + 1 : 256;
      if (tid < 256) sels[tid] = tid < cnt ? (int)selg[(size_t)token * 256 + tid] : 0;
      const bf16_t* qp = (const bf16_t*)(p.ws + OFF_D) + (size_t)token * QLD + (16 * ht + l15) * 544 + 8 * q4;
#pragma unroll
      for (int ks = 0; ks < 17; ++ks) qf[ks] = *(const bf16x8*)(qp + 32 * ks);
      WG_BAR();
      const unsigned char* ckv = p.ws + OFF_CKV + (size_t)(token >> 11) * SEQ * KVLD * 2;
      GATHER_DMA(ckv, 0, lds)
      DMA_WAIT(); WG_BAR(); }
#pragma nounroll
    for (int j = 0; j < nq; ++j) {
        const int token = bid + G * j, qpos = token & 2047, cnt = qpos + 1 < 256 ? qpos + 1 : 256;
        const bool has_nq = j + 1 < nq; const int token_n = token + G, qpos_n = token_n & 2047, cnt_n = qpos_n + 1 < 256 ? qpos_n + 1 : 256;
        bf16_t* qlat = (bf16_t*)(p.ws + OFF_D) + (size_t)token * QLD;
        const unsigned char* ckv = p.ws + OFF_CKV + (size_t)(token >> 11) * SEQ * KVLD * 2;
        const unsigned char* ckv_n = p.ws + OFF_CKV + (size_t)(token_n >> 11) * SEQ * KVLD * 2;
        const int sb = (j & 1) * 256, sbn = ((j + 1) & 1) * 256;
        int t2 = tid; asm volatile("" : "+v"(t2));
        const int l15b = t2 & 15, q4b = (t2 >> 4) & 3;
        if (has_nq && tid < 256) sels[sbn + tid] = tid < cnt_n ? (int)selg[(size_t)token_n * 256 + t2] : 0;
        WG_BAR();
        float lpart = 0.f; f32x4 O[4][2];
        float mref;
        { f32x4 qq = (f32x4){0.f, 0.f, 0.f, 0.f};
#pragma unroll
          for (int ks = 0; ks < 17; ++ks) qq = __builtin_amdgcn_mfma_f32_16x16x32_bf16(qf[ks], qf[ks], qq, 0, 0, 0);
          const int sel3 = l15 & 3; float d = sel3 == 0 ? qq[0] : (sel3 == 1 ? qq[1] : (sel3 == 2 ? qq[2] : qq[3]));
          d = (q4 == (l15 >> 2)) ? d : 0.f; d = sum_xor32(sum_xor16(d));
          mref = sqrtf(d * kmax2) * 1.01f + 1e-3f; }
#pragma unroll
        for (int c = 0; c < 4; ++c) { O[c][0] = (f32x4){0.f, 0.f, 0.f, 0.f}; O[c][1] = (f32x4){0.f, 0.f, 0.f, 0.f}; }
#pragma unroll
        for (int ch = 0; ch < 4; ++ch) {
            LAS unsigned char* Kc = lds + (ch & 1) * 70656; LAS unsigned char* Kn = lds + ((ch & 1) ^ 1) * 70656;
            if (ch < 3) GATHER_DMA(ckv, sb + 64 * (ch + 1), Kn) else if (has_nq) GATHER_DMA(ckv_n, sbn, Kn)
            f32x4 a = (f32x4){0.f, 0.f, 0.f, 0.f};
            const bool act = 64 * ch < cnt;
            if (act) { const unsigned sa = sa0 + (ch & 1) * 70656; bf16x8 k0, k1, k2, k3;
#define S4(K) LDSRD4(k0, k1, k2, k3, sa, (K) * 64, (K) * 64 + 64, (K) * 64 + 128, (K) * 64 + 192); \
              a = __builtin_amdgcn_mfma_f32_16x16x32_bf16(k0, qf[K], a, 0, 0, 0); a = __builtin_amdgcn_mfma_f32_16x16x32_bf16(k1, qf[(K) + 1], a, 0, 0, 0); \
              a = __builtin_amdgcn_mfma_f32_16x16x32_bf16(k2, qf[(K) + 2], a, 0, 0, 0); a = __builtin_amdgcn_mfma_f32_16x16x32_bf16(k3, qf[(K) + 3], a, 0, 0, 0);
              S4(0) S4(4) S4(8) S4(12)
#undef S4
              LDSRD1(k0, sa, 1024); a = __builtin_amdgcn_mfma_f32_16x16x32_bf16(k0, qf[16], a, 0, 0, 0); }
            asm volatile("" ::: "memory");
            if (ch == 3 && has_nq) { const bf16_t* qp = (const bf16_t*)(p.ws + OFF_D) + (size_t)token_n * QLD + (16 * ht + l15b) * 544 + 8 * q4b;
#pragma unroll
                for (int ks = 0; ks < 17; ++ks) qf[ks] = *(const bf16x8*)(qp + 32 * ks); }
            if (act) {
            f32x4 pv; float ps = 0.f;
#pragma unroll
            for (int i = 0; i < 4; ++i) { pv[i] = (64 * ch + 16 * kt + 4 * q4 + i) < cnt ? __builtin_amdgcn_exp2f(a[i] - mref) : 0.f; ps += pv[i]; }
            lpart += ps;
            *(LAS u32x2*)(Pl + (16 * ht + l15) * 144 + (16 * kt + 4 * q4) * 2) = pack4(pv);
            WG_BAR();
            { const unsigned vb = va0 + (ch & 1) * 70656; bf16x8 p0, p1; s16x4 t[4];
#define PVH(S2) LDSRD_PVA(p0, p1, t, pa0, vb, (S2) * 64, (S2) * 35328); \
              _Pragma("unroll") for (int c = 0; c < 2; ++c) { const bf16x8 vf = __builtin_shufflevector(t[2 * c], t[2 * c + 1], 0, 1, 2, 3, 4, 5, 6, 7); \
                  O[c][0] = __builtin_amdgcn_mfma_f32_16x16x32_bf16(vf, p0, O[c][0], 0, 0, 0); O[c][1] = __builtin_amdgcn_mfma_f32_16x16x32_bf16(vf, p1, O[c][1], 0, 0, 0); } \
              LDSRD_PVB(t, vb, (S2) * 35328); \
              _Pragma("unroll") for (int c = 0; c < 2; ++c) { const bf16x8 vf = __builtin_shufflevector(t[2 * c], t[2 * c + 1], 0, 1, 2, 3, 4, 5, 6, 7); \
                  O[2 + c][0] = __builtin_amdgcn_mfma_f32_16x16x32_bf16(vf, p0, O[2 + c][0], 0, 0, 0); O[2 + c][1] = __builtin_amdgcn_mfma_f32_16x16x32_bf16(vf, p1, O[2 + c][1], 0, 0, 0); }
              PVH(0) PVH(1)
#undef PVH
            }
            }
            DMA_WAIT(); WG_BAR();
        }
        lpart = sum_xor32(sum_xor16(lpart));
        if (q4 == 0) lred[kt * 32 + 16 * ht + l15] = lpart;
        WG_BAR();
        const float i0 = 1.f / (lred[l15] + lred[32 + l15] + lred[64 + l15] + lred[96 + l15]), i1 = 1.f / (lred[16 + l15] + lred[48 + l15] + lred[80 + l15] + lred[112 + l15]);
#pragma unroll
        for (int c = 0; c < 4; ++c) if (do_write) { *(u32x2*)(qlat + l15b * 512 + 64 * w + 16 * c + 4 * q4b) = pack4(O[c][0] * i0); *(u32x2*)(qlat + (16 + l15b) * 512 + 64 * w + 16 * c + 4 * q4b) = pack4(O[c][1] * i1); }
    }
#undef GATHER_DMA
#undef DMA_WAIT
}

#define XB_TMO      128
#define XB_XCNT(j)  (256  + 64 * (j))
#define XB_XSUB(j)  (1280 + 64 * (j))
#define XB_XGEN(j)  (2304 + 64 * (j))
#define XB_TOP      3328
#define XB_TOPGEN   3392
#define XCD_BAR_WORDS 3456
#define XB_SPIN_CAP (1u << 20)
__device__ __forceinline__ unsigned xb_ld(unsigned* p)              { return __hip_atomic_load(p, __ATOMIC_RELAXED, __HIP_MEMORY_SCOPE_AGENT); }
__device__ __forceinline__ unsigned xb_add(unsigned* p, unsigned v) { return __hip_atomic_fetch_add(p, v, __ATOMIC_RELAXED, __HIP_MEMORY_SCOPE_AGENT); }
__device__ __forceinline__ unsigned xb_xcc_id() { return (unsigned)__builtin_amdgcn_s_getreg((3 << 11) | 20) & 0xFu; }
#define XB_SPIN(cond, bar) do { unsigned _sp = 0; while (cond) { __builtin_amdgcn_s_sleep(1); \
    if ((++_sp & 255u) == 0u) { if (xb_ld(&(bar)[XB_TMO])) break; if (_sp > XB_SPIN_CAP) { atomicAdd(&(bar)[XB_TMO], 1u); break; } } } } while (0)
struct XcdBarrier { unsigned* bar; unsigned x; volatile LAS unsigned* st; };
__device__ __forceinline__ XcdBarrier xcd_barrier_post(unsigned* bar, volatile LAS unsigned* st) {
    XcdBarrier b; b.bar = bar; b.x = xb_xcc_id(); b.st = st;
    if (threadIdx.x == 0) (void)xb_add(&bar[XB_XCNT(b.x)], 1u);
    return b;
}
__device__ __forceinline__ uint2 xcd_barrier_complete(unsigned* bar, unsigned x) {
    const unsigned G = gridDim.x * gridDim.y * gridDim.z;
    unsigned sum, cnt, mine, sp = 0u;
    for (;;) {
        sum = 0u; cnt = 0u; mine = 0u;
#pragma unroll
        for (unsigned j = 0; j < 16; ++j) { const unsigned c = xb_ld(&bar[XB_XCNT(j)]); sum += c; cnt += (c > 0u) ? 1u : 0u; mine = (j == x) ? c : mine; }
        if (sum == G) break;
        __builtin_amdgcn_s_sleep(1);
        if ((++sp & 255u) == 0u) { if (xb_ld(&bar[XB_TMO])) break; if (sp > XB_SPIN_CAP) { atomicAdd(&bar[XB_TMO], 1u); break; } }
    }
    return make_uint2(mine > 0u ? mine : 1u, cnt > 0u ? cnt : 1u);
}
__device__ __forceinline__ void xcd_barrier(const XcdBarrier& b) {
    asm volatile("s_waitcnt vmcnt(0)" ::: "memory");
    __syncthreads();
    if (threadIdx.x == 0) {
        unsigned* bar = b.bar;
        __builtin_amdgcn_s_waitcnt(0);
        unsigned nloc = b.st[0], nx = b.st[1];
        if (nloc == 0u) { const uint2 r = xcd_barrier_complete(bar, b.x); nloc = r.x; nx = r.y; b.st[0] = nloc; b.st[1] = nx; }
        const unsigned old = xb_add(&bar[XB_XSUB(b.x)], 1u);
        const unsigned gen = old / nloc;
        if (old + 1u == (gen + 1u) * nloc) {
            __builtin_amdgcn_fence(__ATOMIC_RELEASE, "agent");
            asm volatile("s_waitcnt vmcnt(0)" ::: "memory");
            const unsigned og = xb_add(&bar[XB_TOP], 1u);
            const unsigned tg = og / nx;
            if (og + 1u == (tg + 1u) * nx) xb_add(&bar[XB_TOPGEN], 1u);
            else XB_SPIN(xb_ld(&bar[XB_TOPGEN]) == tg, bar);
            __builtin_amdgcn_fence(__ATOMIC_ACQUIRE, "agent");
            xb_add(&bar[XB_XGEN(b.x)], 1u);
            asm volatile("s_waitcnt vmcnt(0)" ::: "memory");
        } else {
            XB_SPIN(xb_ld(&bar[XB_XGEN(b.x)]) == gen, bar);
            __builtin_amdgcn_fence(__ATOMIC_ACQUIRE, "agent");
            asm volatile("s_waitcnt vmcnt(0)" ::: "memory");
        }
    }
    __syncthreads();
}

__global__ void __launch_bounds__(512, 2) fwd_megakernel(Params p) {
    extern __shared__ __attribute__((aligned(16))) unsigned char smem[];
    LAS unsigned char* lds = (LAS unsigned char*)smem;
    cg::grid_group grid = cg::this_grid();
    unsigned char* ws = p.ws; const int G = gridDim.x, bid = blockIdx.x;
    const float2* rope = (const float2*)(ws + OFF_ROPE);
    volatile LAS unsigned* xst = (volatile LAS unsigned*)(lds + LDS_BYTES - 16);
    if (threadIdx.x == 0) { xst[0] = 0u; xst[1] = 0u; }
    __syncthreads();
    const XcdBarrier xb = xcd_barrier_post((unsigned*)(ws + OFF_BAR), xst);
#ifdef ONLY
#define PHASE(n) if ((n) == ONLY)
#else
#define PHASE(n) if (p.ph_lo <= (n) && (n) <= p.ph_hi)
#endif
#define SYNC(n) if (p.ph_lo <= (n) && (n) < p.ph_hi) { if ((n) == 0) grid.sync(); else xcd_barrier(xb); }
#define REP(n) for (int _r = 0, _nr = 1 + ((p.rep >> (n)) & 1); _r < _nr; ++_r)
    PHASE(0) REP(0) { phase0(lds, p); __syncthreads(); }
    SYNC(0);
    PHASE(1) { Sched2D S{(const char*)(ws + OFF_B), (const char*)(ws + OFF_WIN0), (size_t)256 * 4096 * 2, (size_t)256 * 4096 * 2, 32, 48, G, bid};
        EpiProj0 E{(bf16_t*)(ws + OFF_A), rope}; gemm_phase(lds, 4096, 4096, 4096, S, E); }
    SYNC(1);
    PHASE(2) REP(2) { const int rb = (G == 256) ? xcd_run(bid, G) : bid; for (int it = bid; it < 256 + 1536; it += G) { if (it < 256) s5_item(lds, p, G == 256 ? rb : it); else dil_item(lds, p, it - 256 - bid + rb); } }
    SYNC(2);
    PHASE(3) { const int Gg = G >= 256 ? 128 : G / 2;
        Sched2D S{(const char*)(ws + OFF_YBUF), (const char*)(ws + OFF_WGLU), (size_t)256 * 1024 * 2, (size_t)256 * 1024 * 2, 32, 4, Gg, bid};
        EpiGlu E{(const bf16_t*)(ws + OFF_YBUF), (const bf16_t*)(ws + OFF_A), p.glu_b, (bf16_t*)(ws + OFF_MIX)}; gemm_phase(lds, 1024, 1024, 1024, S, E);
        if (bid >= Gg) merge_rows(p, bid - Gg, G - Gg); }
    SYNC(3);
    PHASE(4) { Sched2D S{(const char*)(ws + OFF_MIX), (const char*)(ws + OFF_WOUT0), (size_t)256 * 2048 * 2, (size_t)256 * 2048 * 2, 32, 16, G, bid};
        EpiResid E{p.x, p.out, (bf16_t*)(ws + OFF_B), (float*)(ws + OFF_SSQ)}; gemm_phase(lds, 2048, 2048, 2048, S, E); }
    SYNC(4);
    PHASE(5) { const float* ssq = (const float*)(ws + OFF_SSQ); float* rs1 = (float*)(ws + OFF_RS1);
        for (int row = bid * 512 + threadIdx.x; row < NTOK; row += G * 512) { float s = 0.f; for (int i = 0; i < 64; i += 4) { const f32x4 v = *(const f32x4*)(ssq + (size_t)row * 64 + i); s += (v.x + v.y) + (v.z + v.w); } rs1[row] = rsqrtf(s * (1.f / DM) + EPS); } }
    SYNC(5);
    PHASE(6) { { Sched2D S{(const char*)(ws + OFF_B), (const char*)(ws + OFF_WIN1), (size_t)256 * 4096 * 2, (size_t)256 * 4096 * 2, 32, 24, G, bid};
          EpiProj1 E{(bf16_t*)(ws + OFF_PROJ1), (const float*)(ws + OFF_RS1)}; gemm_phase(lds, 4096, 4096, 4096, S, E); }
        if (G >= 128) {
            if (bid < 64) { SchedGateSplit S{(const char*)(ws + OFF_B), (const char*)(ws + OFF_WIN1), bid}; EpiGatePart E{(float*)(ws + OFF_GP), (const float*)(ws + OFF_RS1)}; gemm_phase(lds, p.k2048, 4096, 4096, S, E); }
            else phase0b(lds, p, bid - 64, G - 64);
        } else { for (int c = bid; c < 64; c += G) { SchedGateSplit S{(const char*)(ws + OFF_B), (const char*)(ws + OFF_WIN1), c}; EpiGatePart E{(float*)(ws + OFF_GP), (const float*)(ws + OFF_RS1)}; gemm_phase(lds, p.k2048, 4096, 4096, S, E); }
            phase0b(lds, p, bid, G); } }
    SYNC(6);
    PHASE(7) phase7(lds, p);
    SYNC(7);
    PHASE(8) { Sched2D S{(const char*)(ws + OFF_PROJ1), (const char*)(ws + OFF_WQ), (size_t)256 * ODD_INP * 2, (size_t)256 * 1536 * 2, 32, 32, G, bid};
        EpiQ E{(bf16_t*)(ws + OFF_QBUF), (bf16_t*)(ws + OFF_B), (const float*)(ws + OFF_RSQ), rope}; gemm_phase(lds, 1536, ODD_INP, 1536, S, E); }
    SYNC(8);
    PHASE(9) {
#ifndef NO9A
 { SchedQlat S{(const char*)(ws + OFF_QBUF), (const char*)(ws + OFF_WUK), G, bid}; EpiQlat E{(bf16_t*)(ws + OFF_D), (const bf16_t*)(ws + OFF_QBUF)}; gemm_phase(lds, p.k128, 4096, 128, S, E); }
#endif
#ifndef NO9B
        { SchedIdx S{(const char*)(ws + OFF_B), (const char*)(ws + OFF_KIDX), G, bid}; EpiIdx E{(float*)(ws + OFF_ISC), (const float*)(ws + OFF_WIDX), (f32x4){0.f, 0.f, 0.f, 0.f}, (f32x4){0.f, 0.f, 0.f, 0.f}, -1}; gemm_phase(lds, p.k128, 128, 128, S, E); }
#endif
 }
    SYNC(9);
    PHASE(10) { const int wid = threadIdx.x >> 6;
#ifndef NO_TOPK
        REP(10) { topk_phase(p); }
#endif
        __threadfence_block(); __syncthreads();
#ifndef NO_DSA
        REP(11) { dsa_phase(lds, p, _r == _nr - 1); __syncthreads(); }
#endif
 }
    SYNC(10);
    PHASE(11) { SchedOVd S{(const char*)(ws + OFF_D), (const char*)(ws + OFF_WUV), G, bid}; EpiOVd E{(bf16_t*)(ws + OFF_B), (const bf16_t*)(ws + OFF_PROJ1), (const float*)(ws + OFF_GP)}; gemm_phase(lds, p.k512, QLD, 512, S, E); }
    SYNC(11);
    PHASE(12) { Sched2D S{(const char*)(ws + OFF_B), (const char*)(ws + OFF_WOUT1), (size_t)256 * 4096 * 2, (size_t)256 * 4096 * 2, 32, 16, G, bid};
        EpiResid E{p.out, p.out, nullptr, (float*)(ws + OFF_SSQ)}; gemm_phase(lds, 4096, 4096, 4096, S, E); }
    SYNC(12);
    PHASE(13) { const float* ssq = (const float*)(ws + OFF_SSQ); const int lane = threadIdx.x & 63, wid = threadIdx.x >> 6;
        for (int row = bid * 8 + wid; row < NTOK; row += G * 8) { const float s = wave_sum(ssq[(size_t)row * 64 + lane]); const float rs = rsqrtf(s * (1.f / DM) + EPS); float* o = p.out + (size_t)row * DM;
#pragma unroll 4
            for (int i = 0; i < 16; ++i) { const int c = (i * 64 + lane) * 4; const f32x4 g = *(const f32x4*)(p.final_norm + c); *(f32x4*)(o + c) = *(const f32x4*)(o + c) * rs * g; } } }
}

#ifndef REPMASK
#define REPMASK 0
#endif
extern "C" void kernel_launch(void* const* d_in, const int* in_sizes, int n_in, void* d_out, int out_size, void* d_ws, size_t ws_size, hipStream_t stream) {
    static int grid_blocks = 0;
    if (!grid_blocks) {
        int dev = 0, cus = 0, per_cu = 0;
        hipGetDevice(&dev);
        hipDeviceGetAttribute(&cus, hipDeviceAttributeMultiprocessorCount, dev);
        hipFuncSetAttribute((const void*)fwd_megakernel, hipFuncAttributeMaxDynamicSharedMemorySize, LDS_BYTES);
        hipOccupancyMaxActiveBlocksPerMultiprocessor(&per_cu, fwd_megakernel, 512, LDS_BYTES);
        if (per_cu > 1) per_cu = 1;
        grid_blocks = cus * per_cu;
        if (ws_size < OFF_END) fprintf(stderr, "workspace too small: %zu < %zu\n", ws_size, (size_t)OFF_END);
    }
    Params p{};
    const float** f = (const float**)&p;
    for (int i = 0; i < 25; ++i) f[i] = (const float*)d_in[i];
    p.out = (float*)d_out; p.ws = (unsigned char*)d_ws; p.ph_lo = 0; p.ph_hi = 13; p.k128 = 128; p.rep = REPMASK; p.k2048 = 2048; p.k512 = 512;
    hipMemsetAsync((unsigned char*)d_ws + OFF_BAR, 0, XCD_BAR_WORDS * 4, stream);
    void* args[] = {&p};
    hipError_t e = hipLaunchCooperativeKernel((void*)fwd_megakernel, dim3(grid_blocks), dim3(512), args, LDS_BYTES, stream);
    if (e != hipSuccess) fprintf(stderr, "cooperative launch failed: %s (grid %d)\n", hipGetErrorString(e), grid_blocks);
}
```

```cpp
#include <hip/hip_runtime.h>
#include <hip/hip_cooperative_groups.h>
#include <cstdio>
namespace cg = cooperative_groups;

#define LAS __attribute__((address_space(3)))
typedef unsigned short bf16_t;
typedef short bf16x8 __attribute__((ext_vector_type(8)));
typedef short s16x4 __attribute__((ext_vector_type(4)));
typedef float f32x4 __attribute__((ext_vector_type(4)));
typedef unsigned u32x4 __attribute__((ext_vector_type(4)));
typedef unsigned u32x2 __attribute__((ext_vector_type(2)));

constexpr int DM = 4096, BATCH = 4, SEQ = 2048, NTOK = BATCH * SEQ;
constexpr int EVEN_IN = 12288, ODD_IN = 6336, ODD_INP = 6400;
constexpr int QLD = 17408;
constexpr int KVLD = 544;
constexpr float EPS = 1e-6f;
constexpr float LOG2E = 1.4426950408889634f;
constexpr float ATT_SCALE = 0.08838834764831845f * LOG2E;

constexpr size_t SZ_WIN1 = (size_t)ODD_INP * 4096 * 2, SZ_WQ = (size_t)8192 * 1536 * 2, SZ_WUK = (size_t)32 * 512 * 128 * 2,
                 SZ_WUV = (size_t)16 * 256 * 1024 * 2, SZ_WOUT1 = (size_t)4096 * 4096 * 2;
constexpr size_t OFF_WIN1 = 0, OFF_WQ = OFF_WIN1 + SZ_WIN1, OFF_WUK = OFF_WQ + SZ_WQ, OFF_WUV = OFF_WUK + SZ_WUK, OFF_WOUT1 = OFF_WUV + SZ_WUV;
constexpr size_t OFF_ROPE = OFF_WOUT1 + SZ_WOUT1;
constexpr size_t OFF_SSQ = OFF_ROPE + 2048 * 16 * 8;
constexpr size_t OFF_RS1 = OFF_SSQ + (size_t)NTOK * 64 * 4;
constexpr size_t OFF_LSE = OFF_RS1 + NTOK * 4;
constexpr size_t OFF_B = OFF_LSE + (size_t)3 * NTOK * 8 * 4;
constexpr size_t OFF_A = OFF_B + (size_t)NTOK * 4096 * 2;
constexpr size_t OFF_PROJ1 = OFF_A, OFF_QBUF = OFF_PROJ1 + (size_t)NTOK * ODD_INP * 2, OFF_CKV = OFF_QBUF + (size_t)NTOK * 4096 * 2,
                 OFF_KIDX = OFF_CKV + (size_t)NTOK * KVLD * 2, OFF_WIDX = OFF_KIDX + (size_t)NTOK * 128 * 2, OFF_RSQ = OFF_WIDX + (size_t)NTOK * 32 * 4,
                 OFF_SEL = OFF_RSQ + NTOK * 4, OFF_A_END = OFF_SEL + (size_t)NTOK * 256 * 2;
constexpr size_t OFF_C = OFF_A + (size_t)NTOK * EVEN_IN * 2;
static_assert(OFF_A_END <= OFF_C, "region A overflow");
constexpr size_t OFF_YBUF = OFF_C, OFF_OBUF = OFF_YBUF + (size_t)NTOK * 1024 * 2, OFF_MIX = OFF_OBUF + (size_t)3 * NTOK * 1024 * 2, OFF_C_END = OFF_MIX + (size_t)NTOK * 2048 * 2;
constexpr size_t OFF_ISC = OFF_C;
static_assert((size_t)NTOK * 2048 * 4 <= OFF_C_END - OFF_C, "iscore");
constexpr size_t OFF_D = OFF_C_END;
constexpr size_t OFF_WIN0 = OFF_D, OFF_WGLU = OFF_WIN0 + (size_t)EVEN_IN * 4096 * 2, OFF_WOUT0 = OFF_WGLU + (size_t)1024 * 1024 * 2;
constexpr size_t OFF_BAR = OFF_D + (size_t)NTOK * QLD * 2;
constexpr size_t OFF_GP = OFF_BAR + 16384;
constexpr size_t OFF_END = OFF_GP + (size_t)2 * NTOK * 256 * 4;

constexpr int LDS_BYTES = 153600;

struct Params {
    const float *x, *even_norm, *even_w_in, *lam_re, *lam_im, *log_step, *b_re, *b_im, *c_re, *c_im, *s5_d, *glu_w, *glu_b, *even_w_out,
        *odd_norm, *odd_w_in, *q_norm, *kv_norm, *idx_k_norm, *w_uq, *w_uk, *w_uv, *w_iq, *odd_w_out, *final_norm;
    float* out; unsigned char* ws; int ph_lo, ph_hi, k128, rep, k2048, k512;
};

__device__ __forceinline__ unsigned cvt_pk_bf16(float lo, float hi) { unsigned r; asm volatile("v_cvt_pk_bf16_f32 %0, %1, %2" : "=v"(r) : "v"(lo), "v"(hi)); return r; }
__device__ __forceinline__ float bf2f(unsigned short b) { return __uint_as_float(((unsigned)b) << 16); }
__device__ __forceinline__ float bflo(unsigned u) { return __uint_as_float(u << 16); }
__device__ __forceinline__ float bfhi(unsigned u) { return __uint_as_float(u & 0xffff0000u); }
__device__ __forceinline__ u32x2 pack4(f32x4 v) { u32x2 r; r.x = cvt_pk_bf16(v.x, v.y); r.y = cvt_pk_bf16(v.z, v.w); return r; }
__device__ __forceinline__ f32x4 unpack4(u32x2 u) { f32x4 r; r.x = bflo(u.x); r.y = bfhi(u.x); r.z = bflo(u.y); r.w = bfhi(u.y); return r; }
__device__ __forceinline__ float silu_f(float z) { return z / (1.f + __expf(-z)); }
__device__ __forceinline__ float sigmoid_f(float z) { return 1.f / (1.f + __expf(-z)); }
typedef unsigned u32x2p_t __attribute__((ext_vector_type(2)));
__device__ __forceinline__ float xor32_val(float v, int lane) { const u32x2p_t r = __builtin_amdgcn_permlane32_swap(__float_as_uint(v), __float_as_uint(v), false, false); return __uint_as_float(lane < 32 ? r.y : r.x); }
__device__ __forceinline__ float sum_xor32(float v) { const u32x2p_t r = __builtin_amdgcn_permlane32_swap(__float_as_uint(v), __float_as_uint(v), false, false); return __uint_as_float(r.x) + __uint_as_float(r.y); }
__device__ __forceinline__ float sum_xor16(float v) { const u32x2p_t r = __builtin_amdgcn_permlane16_swap(__float_as_uint(v), __float_as_uint(v), false, false); return __uint_as_float(r.x) + __uint_as_float(r.y); }
__device__ __forceinline__ float max_xor32(float v) { const u32x2p_t r = __builtin_amdgcn_permlane32_swap(__float_as_uint(v), __float_as_uint(v), false, false); return fmaxf(__uint_as_float(r.x), __uint_as_float(r.y)); }
__device__ __forceinline__ float max_xor16(float v) { const u32x2p_t r = __builtin_amdgcn_permlane16_swap(__float_as_uint(v), __float_as_uint(v), false, false); return fmaxf(__uint_as_float(r.x), __uint_as_float(r.y)); }
__device__ __forceinline__ float wave_sum(float v) {
    v += __int_as_float(__builtin_amdgcn_update_dpp(0, __float_as_int(v), 0xB1, 0xf, 0xf, false));
    v += __int_as_float(__builtin_amdgcn_update_dpp(0, __float_as_int(v), 0x4E, 0xf, 0xf, false));
    v += __int_as_float(__builtin_amdgcn_update_dpp(0, __float_as_int(v), 0x141, 0xf, 0xf, false));
    v += __int_as_float(__builtin_amdgcn_update_dpp(0, __float_as_int(v), 0x140, 0xf, 0xf, false));
    return sum_xor32(sum_xor16(v));
}
__device__ __forceinline__ float row16_sum(float v) {
    v += __int_as_float(__builtin_amdgcn_update_dpp(0, __float_as_int(v), 0xB1, 0xf, 0xf, false));
    v += __int_as_float(__builtin_amdgcn_update_dpp(0, __float_as_int(v), 0x4E, 0xf, 0xf, false));
    v += __int_as_float(__builtin_amdgcn_update_dpp(0, __float_as_int(v), 0x141, 0xf, 0xf, false));
    v += __int_as_float(__builtin_amdgcn_update_dpp(0, __float_as_int(v), 0x140, 0xf, 0xf, false));
    return v;
}

constexpr int BM = 256, BK = 64, HALF = 128, HTB = HALF * BK * 2, NXCD = 8, WGM = 8;
__device__ __forceinline__ int lds_byte(int r, int c) { const int st = (r >> 4) * 2 + (c >> 5), rr = r & 15, cc = c & 31, ob = rr * 64 + cc * 2; return st * 1024 + (ob ^ (((ob >> 9) & 1) << 5)); }
__device__ __forceinline__ int perm32(int rho) { const int n = rho >> 4, i = rho & 15; return 8 * (i >> 2) + 4 * n + (i & 3); }
__device__ __forceinline__ void stage_rc(int b, int& R, int& C) { const int st = b / 1024, sb = b % 1024, swz = sb ^ (((sb >> 9) & 1) << 5); R = (st >> 1) * 16 + swz / 64; C = (st & 1) * 32 + (swz % 64) / 2; }

struct Unit { const char* a; const char* b; int pm, pn, z; };
template <class E, class = void> struct EpiAmap { static constexpr bool v = false; };
template <class E> struct EpiAmap<E, decltype((void)E::AMAP)> { static constexpr bool v = E::AMAP; };
template <class E, class = void> struct EpiPref { static constexpr bool v = false; };
template <class E> struct EpiPref<E, decltype((void)E::PREF)> { static constexpr bool v = E::PREF; };
template <class E, class = void> struct EpiDiag { static constexpr bool v = false; };
template <class E> struct EpiDiag<E, decltype((void)E::DIAG)> { static constexpr bool v = E::DIAG; };

__device__ __forceinline__ void swz_tile(int L, int nM, int nN, int& pm, int& pn) {
    const int nwg = nM * nN; int wgid = L;
    { const int q = nwg / NXCD, r = nwg % NXCD, xcd = wgid % NXCD, off = wgid / NXCD; wgid = (xcd < r ? xcd * (q + 1) : r * (q + 1) + (xcd - r) * q) + off; }
    const int nig = WGM * nN, gid = wgid / nig, fm = gid * WGM, gsz = (nM - fm) < WGM ? (nM - fm) : WGM;
    pm = fm + ((wgid % nig) % gsz); pn = (wgid % nig) / gsz;
}
__device__ __forceinline__ int xcd_run(int c, int G) { return (G & 7) ? c : (c & 7) * (G >> 3) + (c >> 3); }
struct Sched2D {
    const char* A; const char* B; size_t at, bt; int nM, nN, G, c;
    __device__ __forceinline__ bool next(int i, Unit& u) const {
        const long L = (long)i * G + c; if (c >= G || L >= (long)nM * nN) return false;
        swz_tile((int)L, nM, nN, u.pm, u.pn); u.z = 0; u.a = A + (size_t)u.pm * at; u.b = B + (size_t)u.pn * bt; return true; }
};

template <class Epi, class Sched>
__device__ __forceinline__ void gemm_phase(LAS unsigned char* lds, const int K, const int lda, const int ldb, const Sched& S, const Epi& E) {
    const int tid = threadIdx.x, wid = __builtin_amdgcn_readfirstlane(tid >> 6), lane = tid & 63, wr = wid >> 2, wc = wid & 3, fr = lane & 15, fq = lane >> 4;
    const int nt = K / BK;
    unsigned voffA[2], voffB[2];
#pragma unroll
    for (int i = 0; i < 2; ++i) { int R, C; stage_rc(tid * 16 + i * 8192, R, C); const int Rb = Epi::PERM ? ((R & ~31) + perm32(R & 31)) : R; const int Ra = EpiAmap<Epi>::v ? (((R >> 6) * 4 + ((R & 15) >> 2)) * 32 + (R & 3) * 8 + ((R >> 4) & 3)) : R; voffA[i] = (unsigned)(Ra * lda + C) * 2u; voffB[i] = (unsigned)(Rb * ldb + C) * 2u; }
    const size_t kstep = (size_t)(BK * 2);
    const size_t hstepA = EpiDiag<Epi>::v ? (size_t)512 * 2 : (EpiAmap<Epi>::v ? (size_t)4 * lda * 2 : (size_t)HALF * lda * 2), hstepB = (size_t)HALF * ldb * 2;
    const unsigned ldsw = (unsigned)wid * 1024u;
    const int aoff = lds_byte(wr * 64 + fr, fq * 8), boff = lds_byte(wc * 32 + fr, fq * 8);
#define PG8_SA(b, h) (((b) * 2 + (h)) * HTB)
#define PG8_SB(b, h) ((4 + (b) * 2 + (h)) * HTB)
#define PG8_STAGE(bufoff, gbase, voff) do { _Pragma("unroll") for (int _i = 0; _i < 2; ++_i) \
        __builtin_amdgcn_global_load_lds((const unsigned*)((const char*)(gbase) + (voff)[_i]), (LAS unsigned*)(lds + (bufoff) + ldsw + _i * 8192), 16, 0, 0); } while (0)
#define PG8_LDA(dst, b, h) do { _Pragma("unroll") for (int m = 0; m < 4; ++m) _Pragma("unroll") for (int k = 0; k < 2; ++k) dst[m][k] = *(const LAS bf16x8*)(lds + PG8_SA(b, h) + aoff + m * 2048 + k * 1024); } while (0)
#define PG8_LDB(dst, b, h) do { _Pragma("unroll") for (int n = 0; n < 2; ++n) _Pragma("unroll") for (int k = 0; k < 2; ++k) dst[n][k] = *(const LAS bf16x8*)(lds + PG8_SB(b, h) + boff + n * 2048 + k * 1024); } while (0)
#define PG8_MMA(ai, bj, At, Bt) do { __builtin_amdgcn_s_setprio(1); _Pragma("unroll") for (int m = 0; m < 4; ++m) _Pragma("unroll") for (int n = 0; n < 2; ++n) _Pragma("unroll") for (int k = 0; k < 2; ++k) \
        acc[ai][bj][m][n] = __builtin_amdgcn_mfma_f32_16x16x32_bf16(Bt[n][k], At[m][k], acc[ai][bj][m][n], 0, 0, 0); __builtin_amdgcn_s_setprio(0); } while (0)
#define PG8_MMA_OFF(ai, bj, At, Bt) do { if constexpr (!EpiDiag<Epi>::v) PG8_MMA(ai, bj, At, Bt); } while (0)
#define PG8_WAIT_V(n) asm volatile("s_waitcnt vmcnt(" #n ")" ::: "memory")
#define PG8_WAIT_L(n) asm volatile("s_waitcnt lgkmcnt(" #n ")" ::: "memory")
#define PG8_BAR __builtin_amdgcn_s_barrier()
#define PG8_SCHED __builtin_amdgcn_sched_barrier(0)
    Unit cur, nxt; int ui = 0;
    if (!S.next(0, cur)) return;
    f32x4 acc[2][2][4][2];
#pragma unroll
    for (int a = 0; a < 2; ++a)
#pragma unroll
        for (int b = 0; b < 2; ++b)
#pragma unroll
            for (int m = 0; m < 4; ++m)
#pragma unroll
                for (int n = 0; n < 2; ++n) acc[a][b][m][n] = (f32x4){0.f, 0.f, 0.f, 0.f};
    bf16x8 At[4][2], B0[2][2], B1[2][2];
    const char* cA = cur.a; const char* cB = cur.b;
    PG8_STAGE(PG8_SB(0, 0), cB, voffB); PG8_STAGE(PG8_SA(0, 0), cA, voffA); PG8_STAGE(PG8_SB(0, 1), cB + hstepB, voffB); PG8_STAGE(PG8_SA(0, 1), cA + hstepA, voffA);
    if (wr == 1) PG8_BAR;
    PG8_WAIT_V(4); PG8_BAR;
    PG8_STAGE(PG8_SB(1, 0), cB + kstep, voffB); PG8_STAGE(PG8_SA(1, 0), cA + kstep, voffA); PG8_STAGE(PG8_SB(1, 1), cB + hstepB + kstep, voffB);
    PG8_WAIT_V(6); PG8_BAR;
    for (;;) {
        const bool has_next = S.next(ui + 1, nxt);
        const char* nA = has_next ? nxt.a : cA; const char* nB = has_next ? nxt.b : cB;
        for (int t = 0; t < nt; t += 2) {
            const bool last = (t == nt - 2);
            const char* a1 = cA + (size_t)(t + 1) * kstep;
            const char* a2 = last ? nA : cA + (size_t)(t + 2) * kstep; const char* b2 = last ? nB : cB + (size_t)(t + 2) * kstep;
            const char* a3 = a2 + kstep; const char* b3 = b2 + kstep;
            PG8_LDB(B0, 0, 0); PG8_SCHED; PG8_LDA(At, 0, 0); PG8_STAGE(PG8_SA(1, 1), a1 + hstepA, voffA);
            PG8_WAIT_L(8); PG8_BAR; PG8_WAIT_L(0); PG8_MMA(0, 0, At, B0); PG8_BAR; PG8_SCHED;
            PG8_LDB(B1, 0, 1); PG8_STAGE(PG8_SB(0, 0), b2, voffB);
            PG8_BAR; PG8_WAIT_L(0); PG8_MMA_OFF(0, 1, At, B1); PG8_BAR;
            PG8_LDA(At, 0, 1); PG8_STAGE(PG8_SA(0, 0), a2, voffA);
            PG8_BAR; PG8_WAIT_L(0); PG8_MMA_OFF(1, 0, At, B0); PG8_BAR; PG8_SCHED;
            PG8_STAGE(PG8_SB(0, 1), b2 + hstepB, voffB);
            PG8_WAIT_V(6); PG8_BAR; PG8_MMA(1, 1, At, B1); PG8_BAR;
            PG8_LDB(B0, 1, 0); PG8_SCHED; PG8_LDA(At, 1, 0); PG8_STAGE(PG8_SA(0, 1), a2 + hstepA, voffA);
            PG8_WAIT_L(8); PG8_BAR; PG8_WAIT_L(0); PG8_MMA(0, 0, At, B0); PG8_BAR; PG8_SCHED;
            PG8_LDB(B1, 1, 1); PG8_STAGE(PG8_SB(1, 0), b3, voffB);
            PG8_BAR; PG8_WAIT_L(0); PG8_MMA_OFF(0, 1, At, B1); PG8_BAR;
            PG8_LDA(At, 1, 1); PG8_STAGE(PG8_SA(1, 0), a3, voffA);
            PG8_BAR; PG8_WAIT_L(0); PG8_MMA_OFF(1, 0, At, B0); PG8_BAR; PG8_SCHED;
            PG8_STAGE(PG8_SB(1, 1), b3 + hstepB, voffB);
            PG8_WAIT_V(6); PG8_BAR; PG8_MMA(1, 1, At, B1); PG8_BAR;
        }
        E(acc, cur, wr, wc, fr, fq);
        if (!has_next) break;
        if constexpr (EpiPref<Epi>::v) E.prefetch(nxt, wr, fr);
#pragma unroll
        for (int a = 0; a < 2; ++a)
#pragma unroll
            for (int b = 0; b < 2; ++b)
#pragma unroll
                for (int m = 0; m < 4; ++m)
#pragma unroll
                    for (int n = 0; n < 2; ++n) acc[a][b][m][n] = (f32x4){0.f, 0.f, 0.f, 0.f};
        cur = nxt; cA = nA; cB = nB; ++ui;
    }
    PG8_WAIT_V(0);
    if (wr == 0) PG8_BAR;
    PG8_BAR;
#undef PG8_SA
#undef PG8_SB
#undef PG8_STAGE
#undef PG8_LDA
#undef PG8_LDB
#undef PG8_MMA
#undef PG8_MMA_OFF
#undef PG8_WAIT_V
#undef PG8_WAIT_L
#undef PG8_BAR
#undef PG8_SCHED
}

typedef const f32x4 (&AccRef)[2][2][4][2];
#define EPI_ROWLOOP for (int ai = 0; ai < 2; ++ai) for (int m = 0; m < 4; ++m)
#define EPI_ROW(u) ((u).pm * BM + ai * HALF + wr * 64 + m * 16 + fr)
#define EPI_COL(u) ((u).pn * BM + bj * HALF + wc * 32 + n * 16 + 4 * fq)

#define EPI_COL8(u) ((u).pn * BM + bj * HALF + wc * 32 + 8 * fq)
__device__ __forceinline__ u32x4 pack8(f32x4 a, f32x4 b) { u32x4 r; r.x = cvt_pk_bf16(a.x, a.y); r.y = cvt_pk_bf16(a.z, a.w); r.z = cvt_pk_bf16(b.x, b.y); r.w = cvt_pk_bf16(b.z, b.w); return r; }
__device__ __forceinline__ void unpack8(u32x4 u, f32x4& a, f32x4& b) { a.x = bflo(u.x); a.y = bfhi(u.x); a.z = bflo(u.y); a.w = bfhi(u.y); b.x = bflo(u.z); b.y = bfhi(u.z); b.z = bflo(u.w); b.w = bfhi(u.w); }
struct RopeCS { float2 c[8]; };
__device__ __forceinline__ RopeCS rope_load(const float2* tab, int pos, int fq) { RopeCS r; const float2* t = tab + pos * 16 + 8 * (fq & 1);
#pragma unroll
    for (int e = 0; e < 8; ++e) r.c[e] = t[e];
    return r; }
__device__ __forceinline__ void rope_apply(f32x4& v0, f32x4& v1, const RopeCS& r, int fq) {
    const bool lo = fq < 2;
#pragma unroll
    for (int e = 0; e < 4; ++e) { const float o0 = xor32_val(v0[e], lo ? 0 : 32), o1 = xor32_val(v1[e], lo ? 0 : 32); const float2 c0 = r.c[e], c1 = r.c[4 + e];
        v0[e] = lo ? (v0[e] * c0.x - o0 * c0.y) : (v0[e] * c0.x + o0 * c0.y); v1[e] = lo ? (v1[e] * c1.x - o1 * c1.y) : (v1[e] * c1.x + o1 * c1.y); }
}
#define EPI_ROW_(u, ai, m) ((u).pm * BM + (ai) * HALF + wr * 64 + (m) * 16 + fr)

struct EpiProj0 {
    static constexpr bool PERM = true;
    bf16_t* out; const float2* rope;
    __device__ __forceinline__ void operator()(AccRef acc, const Unit& u, int wr, int wc, int fr, int fq) const {
        const int rel = u.pn * BM - 2048; const bool qk = rel >= 0 && rel < 9216 && (rel % 3072) < 2048; const bool isq = qk && (rel % 3072) < 1024;
        const float sc = isq ? ATT_SCALE : 1.f; const bool dorope = qk && wc == 0;
#pragma unroll
        for (int ai = 0; ai < 2; ++ai)
#pragma unroll
            for (int mh = 0; mh < 2; ++mh) { RopeCS cs[2];
                if (dorope) { cs[0] = rope_load(rope, EPI_ROW_(u, ai, 2 * mh) & 2047, fq); cs[1] = rope_load(rope, EPI_ROW_(u, ai, 2 * mh + 1) & 2047, fq); }
#pragma unroll
                for (int mm = 0; mm < 2; ++mm) { const int m = 2 * mh + mm, row = EPI_ROW_(u, ai, m);
#pragma unroll
                    for (int bj = 0; bj < 2; ++bj) { f32x4 v0 = acc[ai][bj][m][0], v1 = acc[ai][bj][m][1];
                        if (dorope) rope_apply(v0, v1, cs[mm], fq);
                        *(u32x4*)(out + (size_t)row * EVEN_IN + EPI_COL8(u)) = pack8(v0 * sc, v1 * sc); } } }
    }
};
struct EpiGlu {
    static constexpr bool PERM = true;
    const bf16_t* y; const bf16_t* proj0; const float* bias; bf16_t* mix;
    __device__ __forceinline__ void operator()(AccRef acc, const Unit& u, int wr, int wc, int fr, int fq) const {
        f32x4 bv[2][2];
#pragma unroll
        for (int bj = 0; bj < 2; ++bj) { const int col = EPI_COL8(u); bv[bj][0] = *(const f32x4*)(bias + col); bv[bj][1] = *(const f32x4*)(bias + col + 4); }
#pragma unroll
        for (int ai = 0; ai < 2; ++ai)
#pragma unroll
            for (int mh = 0; mh < 2; ++mh) { u32x4 yv[2][2], zv[2][2];
#pragma unroll
                for (int mm = 0; mm < 2; ++mm)
#pragma unroll
                    for (int bj = 0; bj < 2; ++bj) { const int row = EPI_ROW_(u, ai, 2 * mh + mm), col = EPI_COL8(u);
                        yv[mm][bj] = *(const u32x4*)(y + (size_t)row * 1024 + col); zv[mm][bj] = *(const u32x4*)(proj0 + (size_t)row * EVEN_IN + 1024 + col); }
#pragma unroll
                for (int mm = 0; mm < 2; ++mm)
#pragma unroll
                    for (int bj = 0; bj < 2; ++bj) { const int m = 2 * mh + mm, row = EPI_ROW_(u, ai, m), col = EPI_COL8(u); f32x4 y0, y1, z0, z1, r0, r1;
                        unpack8(yv[mm][bj], y0, y1); unpack8(zv[mm][bj], z0, z1);
#pragma unroll
                        for (int e = 0; e < 4; ++e) { r0[e] = y0[e] * sigmoid_f(acc[ai][bj][m][0][e] + bv[bj][0][e]) * silu_f(z0[e]); r1[e] = y1[e] * sigmoid_f(acc[ai][bj][m][1][e] + bv[bj][1][e]) * silu_f(z1[e]); }
                        *(u32x4*)(mix + (size_t)row * 2048 + col) = pack8(r0, r1); } }
    }
};
struct EpiResid {
    static constexpr bool PERM = true;
    const float* xin; float* xo; bf16_t* xb; float* ssq;
    __device__ __forceinline__ void operator()(AccRef acc, const Unit& u, int wr, int wc, int fr, int fq) const {
#pragma unroll
        for (int ai = 0; ai < 2; ++ai)
#pragma unroll
            for (int mh = 0; mh < 2; ++mh) { f32x4 xv[2][2][2];
#pragma unroll
                for (int mm = 0; mm < 2; ++mm)
#pragma unroll
                    for (int bj = 0; bj < 2; ++bj) { const size_t o = (size_t)EPI_ROW_(u, ai, 2 * mh + mm) * DM + EPI_COL8(u); xv[mm][bj][0] = *(const f32x4*)(xin + o); xv[mm][bj][1] = *(const f32x4*)(xin + o + 4); }
#pragma unroll
                for (int mm = 0; mm < 2; ++mm) { const int m = 2 * mh + mm, row = EPI_ROW_(u, ai, m); float ss = 0.f;
#pragma unroll
                    for (int bj = 0; bj < 2; ++bj) { const size_t o = (size_t)row * DM + EPI_COL8(u);
                        const f32x4 v0 = xv[mm][bj][0] + acc[ai][bj][m][0], v1 = xv[mm][bj][1] + acc[ai][bj][m][1];
                        *(f32x4*)(xo + o) = v0; *(f32x4*)(xo + o + 4) = v1;
                        if (xb) *(u32x4*)(xb + o) = pack8(v0, v1);
                        ss += v0.x * v0.x + v0.y * v0.y + v0.z * v0.z + v0.w * v0.w + v1.x * v1.x + v1.y * v1.y + v1.z * v1.z + v1.w * v1.w; }
                    ss = sum_xor16(ss); ss = sum_xor32(ss);
                    if (fq == 0) ssq[(size_t)row * 64 + u.pn * 4 + wc] = ss; } }
    }
};
struct EpiProj1 {
    static constexpr bool PERM = true;
    bf16_t* out; const float* rs;
    __device__ __forceinline__ void operator()(AccRef acc, const Unit& u, int wr, int wc, int fr, int fq) const {
        float rsv[2][4];
#pragma unroll
        EPI_ROWLOOP rsv[ai][m] = rs[EPI_ROW(u)];
#pragma unroll
        EPI_ROWLOOP { const int row = EPI_ROW(u); const float s = rsv[ai][m];
#pragma unroll
            for (int bj = 0; bj < 2; ++bj) *(u32x4*)(out + (size_t)row * ODD_INP + EPI_COL8(u)) = pack8(acc[ai][bj][m][0] * s, acc[ai][bj][m][1] * s); }
    }
};
struct EpiQ {
    static constexpr bool PERM = true;
    bf16_t* qbuf; bf16_t* qidx; const float* rs; const float2* rope; bf16_t* qlat;
    __device__ __forceinline__ void operator()(AccRef acc, const Unit& u, int wr, int wc, int fr, int fq) const {
        bf16_t* base = u.pn < 16 ? qbuf : qidx; const int colt = (u.pn & 15) * BM;
        float rsv[2][4];
#pragma unroll
        EPI_ROWLOOP rsv[ai][m] = rs[EPI_ROW(u)];
#pragma unroll
        for (int ai = 0; ai < 2; ++ai)
#pragma unroll
            for (int mh = 0; mh < 2; ++mh) { RopeCS cs[2];
                if (wc == 0) { cs[0] = rope_load(rope, EPI_ROW_(u, ai, 2 * mh) & 2047, fq); cs[1] = rope_load(rope, EPI_ROW_(u, ai, 2 * mh + 1) & 2047, fq); }
#pragma unroll
                for (int mm = 0; mm < 2; ++mm) { const int m = 2 * mh + mm, row = EPI_ROW_(u, ai, m); const float s = rsv[ai][m];
#pragma unroll
                    for (int bj = 0; bj < 2; ++bj) { f32x4 v0 = acc[ai][bj][m][0] * s, v1 = acc[ai][bj][m][1] * s;
                        if (wc == 0) { rope_apply(v0, v1, cs[mm], fq);
                            if (u.pn < 16) *(u32x4*)(qlat + (size_t)row * QLD + (u.pn * 2 + bj) * 544 + 512 + 8 * fq) = pack8(v0 * ATT_SCALE, v1 * ATT_SCALE); }
                        *(u32x4*)(base + (size_t)row * 4096 + colt + bj * HALF + wc * 32 + 8 * fq) = pack8(v0, v1); } } }
    }
};
struct EpiQlat {
    static constexpr bool PERM = true;
    bf16_t* qlat; const bf16_t* qbuf;
    __device__ __forceinline__ void operator()(AccRef acc, const Unit& u, int wr, int wc, int fr, int fq) const {
#pragma unroll
        EPI_ROWLOOP { const int row = EPI_ROW(u); bf16_t* o = qlat + (size_t)row * QLD + u.z * 544;
#pragma unroll
            for (int bj = 0; bj < 2; ++bj) *(u32x4*)(o + EPI_COL8(u)) = pack8(acc[ai][bj][m][0], acc[ai][bj][m][1]); }
    }
};
struct EpiIdx {       static constexpr bool PERM = false, AMAP = true, PREF = true;
    float* isc; const float* widx; mutable f32x4 pwa, pwb; mutable int ptok;
    __device__ __forceinline__ void prefetch(const Unit& n, int wr, int fr) const { const int t = n.pm * 8 + wr * 4 + (fr >> 2); ptok = t; pwa = *(const f32x4*)(widx + t * 32 + (fr & 3) * 8); pwb = *(const f32x4*)(widx + t * 32 + (fr & 3) * 8 + 4); }
    __device__ __forceinline__ void operator()(AccRef acc, const Unit& u, int wr, int wc, int fr, int fq) const {
        const int token = u.pm * 8 + wr * 4 + (fr >> 2);
        f32x4 wa = pwa, wb = pwb;
        if (ptok != token) { wa = *(const f32x4*)(widx + token * 32 + (fr & 3) * 8); wb = *(const f32x4*)(widx + token * 32 + (fr & 3) * 8 + 4); }
        float* orow = isc + (size_t)token * 2048 + u.pn * BM + wc * 32 + 4 * fq;
#pragma unroll
        for (int bj = 0; bj < 2; ++bj)
#pragma unroll
            for (int n = 0; n < 2; ++n) { f32x4 r;
#pragma unroll
                for (int e = 0; e < 4; ++e) { float v = 0.f;
#pragma unroll
                    for (int m = 0; m < 4; ++m) { v += wa[m] * fmaxf(acc[0][bj][m][n][e], 0.f); v += wb[m] * fmaxf(acc[1][bj][m][n][e], 0.f); }
                    v += __int_as_float(__builtin_amdgcn_update_dpp(0, __float_as_int(v), 0xB1, 0xf, 0xf, false));
                    v += __int_as_float(__builtin_amdgcn_update_dpp(0, __float_as_int(v), 0x4E, 0xf, 0xf, false));
                    r[e] = v; }
                if ((fr & 3) == 0) *(f32x4*)(orow + bj * HALF + n * 16) = r; }
    }
};
struct EpiOV {
    static constexpr bool PERM = true;
    bf16_t* og; const bf16_t* proj1; const float* gp;
    __device__ __forceinline__ void operator()(AccRef acc, const Unit& u, int wr, int wc, int fr, int fq) const {
        if (u.pn != 15) {
#pragma unroll
            for (int ai = 0; ai < 2; ++ai) { u32x4 gv[4][2];
#pragma unroll
                for (int m = 0; m < 4; ++m)
#pragma unroll
                    for (int bj = 0; bj < 2; ++bj) gv[m][bj] = *(const u32x4*)(proj1 + (size_t)EPI_ROW_(u, ai, m) * ODD_INP + 2240 + EPI_COL8(u));
#pragma unroll
                for (int m = 0; m < 4; ++m)
#pragma unroll
                    for (int bj = 0; bj < 2; ++bj) { f32x4 g0, g1, r0, r1; unpack8(gv[m][bj], g0, g1);
#pragma unroll
                        for (int e = 0; e < 4; ++e) { r0[e] = acc[ai][bj][m][0][e] * silu_f(g0[e]); r1[e] = acc[ai][bj][m][1][e] * silu_f(g1[e]); }
                        *(u32x4*)(og + (size_t)EPI_ROW_(u, ai, m) * 4096 + EPI_COL8(u)) = pack8(r0, r1); } }
        } else {
#pragma unroll
        EPI_ROWLOOP { const int row = EPI_ROW(u);
#pragma unroll
            for (int bj = 0; bj < 2; ++bj) { const int col = EPI_COL8(u); f32x4 g0, g1;
                if (col >= 3904) { const float* g = gp + (size_t)row * 256 + (col - 3904); g0 = *(const f32x4*)g + *(const f32x4*)(g + (size_t)NTOK * 256); g1 = *(const f32x4*)(g + 4) + *(const f32x4*)(g + (size_t)NTOK * 256 + 4); }
                else unpack8(*(const u32x4*)(proj1 + (size_t)row * ODD_INP + 2240 + col), g0, g1);
                f32x4 r0, r1;
#pragma unroll
                for (int e = 0; e < 4; ++e) { r0[e] = acc[ai][bj][m][0][e] * silu_f(g0[e]); r1[e] = acc[ai][bj][m][1][e] * silu_f(g1[e]); }
                *(u32x4*)(og + (size_t)row * 4096 + col) = pack8(r0, r1); } }
        }
    }
};

struct EpiOVd {
    static constexpr bool PERM = true, DIAG = true;
    bf16_t* og; const bf16_t* proj1; const float* gp;
    __device__ __forceinline__ void operator()(AccRef acc, const Unit& u, int wr, int wc, int fr, int fq) const {
#pragma unroll
        for (int ai = 0; ai < 2; ++ai) { const int col = u.pn * 256 + ai * 128 + wc * 32 + 8 * fq; f32x4 g0[4], g1[4];
#pragma unroll
            for (int m = 0; m < 4; ++m) { const int row = u.pm * 128 + wr * 64 + m * 16 + fr;
                if (col >= 3904) { const float* g = gp + (size_t)row * 256 + (col - 3904); g0[m] = *(const f32x4*)g + *(const f32x4*)(g + (size_t)NTOK * 256); g1[m] = *(const f32x4*)(g + 4) + *(const f32x4*)(g + (size_t)NTOK * 256 + 4); }
                else unpack8(*(const u32x4*)(proj1 + (size_t)row * ODD_INP + 2240 + col), g0[m], g1[m]); }
#pragma unroll
            for (int m = 0; m < 4; ++m) { const int row = u.pm * 128 + wr * 64 + m * 16 + fr; f32x4 r0, r1;
#pragma unroll
                for (int e = 0; e < 4; ++e) { r0[e] = acc[ai][ai][m][0][e] * silu_f(g0[m][e]); r1[e] = acc[ai][ai][m][1][e] * silu_f(g1[m][e]); }
                *(u32x4*)(og + (size_t)row * 4096 + col) = pack8(r0, r1); } }
    }
};
struct SchedOVd {
    const char* olat; const char* wuv; int G, c;
    __device__ __forceinline__ bool next(int i, Unit& u) const {
        const int L = i * G + xcd_run(c, G); if (L >= 1024) return false;
        u.pn = L >> 6; u.pm = L & 63; u.z = 0;
        u.a = olat + ((size_t)u.pm * 128 * QLD + u.pn * 1024) * 2; u.b = wuv + (size_t)u.pn * 256 * 512 * 2; return true; }
};
struct EpiGatePart {
    static constexpr bool PERM = true;
    float* gp; const float* rs;
    __device__ __forceinline__ void operator()(AccRef acc, const Unit& u, int wr, int wc, int fr, int fq) const {
        float rsv[2][4];
#pragma unroll
        EPI_ROWLOOP rsv[ai][m] = rs[EPI_ROW(u)];
#pragma unroll
        EPI_ROWLOOP { const int row = EPI_ROW(u); const float s = rsv[ai][m]; float* o = gp + ((size_t)u.z * NTOK + row) * 256 + wc * 32 + 8 * fq;
#pragma unroll
            for (int bj = 0; bj < 2; ++bj) { *(f32x4*)(o + bj * HALF) = acc[ai][bj][m][0] * s; *(f32x4*)(o + bj * HALF + 4) = acc[ai][bj][m][1] * s; } }
    }
};
struct SchedGateSplit {
    const char* A; const char* B; int c;
    __device__ __forceinline__ bool next(int i, Unit& u) const {
        if (i > 0 || c >= 64) return false;
        u.pm = c >> 1; u.z = c & 1; u.pn = 0;
        u.a = A + ((size_t)u.pm * 256 * 4096 + u.z * 2048) * 2; u.b = B + ((size_t)24 * 256 * 4096 + u.z * 2048) * 2; return true; }
};
struct SchedQlat {
    const char* qbuf; const char* wuk; int G, c;
    __device__ __forceinline__ bool next(int i, Unit& u) const {
        const int L = i * G + xcd_run(c, G); if (L >= 2048) return false;
        u.z = L >> 6; u.pm = (L & 63) >> 1; u.pn = L & 1;
        u.a = qbuf + ((size_t)u.pm * 256 * 4096 + u.z * 128) * 2; u.b = wuk + ((size_t)u.z * 512 + u.pn * 256) * 128 * 2; return true; }
};
struct SchedIdx {
    const char* qidx; const char* kidx; int G, c;
    __device__ __forceinline__ bool next(int i, Unit& u) const {
        const int L = i * G + xcd_run(c, G); if (L >= 4 * 1120) return false;
        const int b = L / 1120, r = L % 1120 + 32; int j = 0;
#pragma unroll
        for (int t = 1; t < 8; ++t) if (r >= 16 * t * (t + 1)) j = t;
        const int rr = r - 16 * j * (j + 1), pml = 32 * j + rr / (j + 1); u.pn = rr % (j + 1); u.pm = b * 256 + pml; u.z = b;
        u.a = qidx + (size_t)u.pm * 8 * 4096 * 2; u.b = kidx + ((size_t)b * 2048 + u.pn * 256) * 128 * 2; return true; }
};
struct SchedOV {
    const char* olat; const char* wuv; int G, c;
    __device__ __forceinline__ bool next(int i, Unit& u) const {
        const int L = i * G + c; if (L >= 512) return false;
        u.pn = L >> 5; u.pm = L & 31; u.z = 0;
        u.a = olat + ((size_t)u.pm * 256 * QLD + u.pn * 1024) * 2; u.b = wuv + (size_t)u.pn * 256 * 1024 * 2; return true; }
};

struct ConvJob { const float* src; const float* gain; bf16_t* dst; int N, kt, nt, ldd, mode; };
struct ConvRegs { f32x4 v[2]; float g[2]; };
__device__ __forceinline__ void conv_load(const ConvJob& j, ConvRegs& r) {
    const int tid = threadIdx.x;
#pragma unroll
    for (int i = 0; i < 2; ++i) { const int row = (tid >> 4) + 32 * i, c4 = (tid & 15) * 4;
        r.v[i] = *(const f32x4*)(j.src + (size_t)(j.kt * 64 + row) * j.N + j.nt * 64 + c4); r.g[i] = j.gain ? j.gain[j.kt * 64 + row] : 1.f; }
}
#define CONV_BAR() do { asm volatile("s_waitcnt lgkmcnt(0)" ::: "memory"); __builtin_amdgcn_s_barrier(); asm volatile("" ::: "memory"); } while (0)
__device__ __forceinline__ void conv_store(LAS float* tile, const ConvJob& j, const ConvRegs& r) {
    const int tid = threadIdx.x, k0 = j.kt * 64, n0 = j.nt * 64;
    CONV_BAR();
#pragma unroll
    for (int i = 0; i < 2; ++i) { const int row = (tid >> 4) + 32 * i, c4 = (tid & 15) * 4; const f32x4 v = r.v[i] * r.g[i];
        LAS float* t = tile + row * 65 + c4; t[0] = v.x; t[1] = v.y; t[2] = v.z; t[3] = v.w; }
    CONV_BAR();
    const int n = tid >> 3, kc = (tid & 7) * 8; float f[8];
#pragma unroll
    for (int q = 0; q < 8; ++q) f[q] = tile[(kc + q) * 65 + n];
    u32x4 o; o.x = cvt_pk_bf16(f[0], f[1]); o.y = cvt_pk_bf16(f[2], f[3]); o.z = cvt_pk_bf16(f[4], f[5]); o.w = cvt_pk_bf16(f[6], f[7]);
    const int gn = n0 + n, gk = k0 + kc;
    if (j.mode == 0) *(u32x4*)(j.dst + (size_t)gn * j.ldd + gk) = o;
    else { const int h = gn >> 7, dv = gn & 127; bf16_t* rr = j.dst + ((size_t)(h >> 1) * 256 + (h & 1) * 128 + dv) * 1024;
        *(u32x4*)(rr + (h & 1) * 512 + gk) = o; *(u32x4*)(rr + ((h & 1) ^ 1) * 512 + gk) = (u32x4){0u, 0u, 0u, 0u}; }
}
__device__ __forceinline__ ConvJob conv_job_a(const Params& p, int t) {
    constexpr int T0 = 64 * 192, T1 = T0 + 16 * 16, T2 = T1 + 32 * 64; unsigned char* ws = p.ws; ConvJob j;
    if (t < T0)      { j = ConvJob{p.even_w_in, nullptr, (bf16_t*)(ws + OFF_WIN0), 12288, t / 192, t % 192, 4096, 0}; }
    else if (t < T1) { const int l = t - T0; j = ConvJob{p.glu_w, nullptr, (bf16_t*)(ws + OFF_WGLU), 1024, l / 16, l % 16, 1024, 0}; }
    else if (t < T2) { const int l = t - T1; j = ConvJob{p.even_w_out, nullptr, (bf16_t*)(ws + OFF_WOUT0), 4096, l / 64, l % 64, 2048, 0}; }
    else             { const int l = t - T2; j = ConvJob{p.odd_w_in, p.odd_norm, (bf16_t*)(ws + OFF_WIN1), ODD_IN, l / 99, l % 99, 4096, 0}; }
    return j;
}
__device__ __forceinline__ ConvJob conv_job_b(const Params& p, int t) {
    constexpr int T4 = 24 * 64, T5 = T4 + 24 * 64, T6 = T5 + 8 * 64; unsigned char* ws = p.ws; ConvJob j;
    if (t < T4)      { j = ConvJob{p.w_uq, p.q_norm, (bf16_t*)(ws + OFF_WQ), 4096, t / 64, t % 64, 1536, 0}; }
    else if (t < T5) { const int l = t - T4; j = ConvJob{p.w_iq, p.q_norm, (bf16_t*)(ws + OFF_WQ) + (size_t)4096 * 1536, 4096, l / 64, l % 64, 1536, 0}; }
    else if (t < T6) { const int l = t - T5; j = ConvJob{p.w_uv, nullptr, (bf16_t*)(ws + OFF_WUV), 4096, l / 64, l % 64, 512, 0}; }
    else             { const int l = t - T6; j = ConvJob{p.odd_w_out, nullptr, (bf16_t*)(ws + OFF_WOUT1), 4096, l / 64, l % 64, 4096, 0}; }
    return j;
}
template <bool PARTB>
__device__ __forceinline__ void conv_run(LAS unsigned char* lds, const Params& p, int first, int stride, int total) {
    if (first >= total) return;
    LAS float* tile = (LAS float*)lds;
    ConvJob cur = PARTB ? conv_job_b(p, first) : conv_job_a(p, first); ConvRegs rc; conv_load(cur, rc);
#pragma nounroll
    for (int t = first; t < total; t += stride) {
        const bool has_next = t + stride < total; const ConvJob nxt = PARTB ? conv_job_b(p, has_next ? t + stride : t) : conv_job_a(p, has_next ? t + stride : t);
        ConvRegs rn; if (has_next) conv_load(nxt, rn); else rn = rc;
        conv_store(tile, cur, rc);
        cur = nxt; rc = rn;
    }
}

__device__ __forceinline__ void phase0(LAS unsigned char* lds, const Params& p) {
    unsigned char* ws = p.ws; const int G = gridDim.x, bid = blockIdx.x, tid = threadIdx.x, lane = tid & 63, wid = tid >> 6;
    { bf16_t* h0 = (bf16_t*)(ws + OFF_B);
      for (int row = bid * 8 + wid; row < NTOK; row += G * 8) { const float* xr = p.x + (size_t)row * DM; f32x4 v[16]; float ss = 0.f;
#pragma unroll
          for (int i = 0; i < 16; ++i) { v[i] = *(const f32x4*)(xr + (i * 64 + lane) * 4); ss += v[i].x * v[i].x + v[i].y * v[i].y + v[i].z * v[i].z + v[i].w * v[i].w; }
          ss = wave_sum(ss); const float rs = rsqrtf(ss * (1.f / DM) + EPS);
#pragma unroll
          for (int i = 0; i < 16; ++i) { const f32x4 g = *(const f32x4*)(p.even_norm + (i * 64 + lane) * 4); *(u32x2*)(h0 + (size_t)row * DM + (i * 64 + lane) * 4) = pack4(v[i] * rs * g); } } }
    { float2* tab = (float2*)(ws + OFF_ROPE);
      for (int i = bid * 512 + tid; i < 2048 * 16; i += G * 512) { const int pos = i >> 4, j = i & 15; const float inv = powf(500000.f, -(float)(2 * j) / 32.f); const float ang = (float)pos * inv; tab[i] = make_float2(cosf(ang), sinf(ang)); } }
    { u32x4* d = (u32x4*)(ws + OFF_WIN1 + (size_t)ODD_IN * 4096 * 2);
      for (int i = bid * 512 + tid; i < 64 * 4096 * 2 / 16; i += G * 512) d[i] = (u32x4){0u, 0u, 0u, 0u}; }
    conv_run<false>(lds, p, bid, G, 64 * 192 + 16 * 16 + 32 * 64 + 64 * 99);
}

__device__ __forceinline__ void phase0b(LAS unsigned char* lds, const Params& p, int rank, int n) {
    unsigned char* ws = p.ws; const int tid = threadIdx.x;
    { bf16_t* d = (bf16_t*)(ws + OFF_WUK);
      for (int i = rank * 512 + tid; i < 32 * 512 * 16; i += n * 512) { const int kc = i & 15, c = (i >> 4) & 511, h = i >> 13; u32x4 o = (u32x4){0u, 0u, 0u, 0u};
          if (kc >= 4) { const float* sp = p.w_uk + ((size_t)c * 32 + h) * 96 + (kc - 4) * 8; const f32x4 a = *(const f32x4*)sp * ATT_SCALE, b = *(const f32x4*)(sp + 4) * ATT_SCALE;
              o.x = cvt_pk_bf16(a.x, a.y); o.y = cvt_pk_bf16(a.z, a.w); o.z = cvt_pk_bf16(b.x, b.y); o.w = cvt_pk_bf16(b.z, b.w); }
          *(u32x4*)(d + ((size_t)h * 512 + c) * 128 + kc * 8) = o; } }
    conv_run<true>(lds, p, rank, n, 24 * 64 + 24 * 64 + 8 * 64 + 64 * 64);
}

__device__ __forceinline__ void s5_item(LAS unsigned char* lds, const Params& p, int item) {
    const int b = item >> 6, g = item & 63, tid = threadIdx.x, lane = tid & 63, wid = tid >> 6, l15 = lane & 15, q4 = lane >> 4;
    const bf16_t* proj0 = (const bf16_t*)(p.ws + OFF_A); bf16_t* ybuf = (bf16_t*)(p.ws + OFF_YBUF);
    LAS unsigned char* u_s = lds;
    LAS unsigned char* W_s = lds + 65536 + wid * 8448;
    LAS float* carry = (LAS float*)(lds + 65536 + 8 * 8448);
    LAS float* cst = carry + 1024;
    __syncthreads();
    for (int i = tid; i < 4096; i += 512) { const int t = i >> 1, hf = i & 1; *(LAS u32x4*)(u_s + t * 32 + hf * 16) = *(const u32x4*)(proj0 + (size_t)(b * SEQ + t) * EVEN_IN + g * 16 + hf * 8); }
    const int gp = g * 64 + lane;
    const float lr = fminf(p.lam_re[gp], -1e-4f), li = p.lam_im[gp], dt = expf(p.log_step[g]);
    const float mag = expf(lr * dt), ar = mag * cosf(li * dt), ai = mag * sinf(li * dt);
    { const float den = lr * lr + li * li, nr = ar - 1.f, ni = ai;
      if (wid == 0) { cst[lane * 4] = ar; cst[lane * 4 + 1] = ai; cst[lane * 4 + 2] = (nr * lr + ni * li) / den; cst[lane * 4 + 3] = (ni * lr - nr * li) / den; } }
    bf16x8 cf[4];
#pragma unroll
    for (int kb = 0; kb < 4; ++kb) { const float* sp = (kb < 2 ? p.c_re : p.c_im) + ((size_t)g * 16 + l15) * 64 + (kb & 1) * 32 + 8 * q4; const float sg = kb < 2 ? 1.f : -1.f;
        const f32x4 a = *(const f32x4*)sp * sg, c = *(const f32x4*)(sp + 4) * sg; u32x4 o; o.x = cvt_pk_bf16(a.x, a.y); o.y = cvt_pk_bf16(a.z, a.w); o.z = cvt_pk_bf16(c.x, c.y); o.w = cvt_pk_bf16(c.z, c.w);
        cf[kb] = __builtin_bit_cast(bf16x8, o); }
    const float dsk = p.s5_d[g * 16 + l15];
    __syncthreads();
    bf16x8 bre[4], bim[4];
#pragma unroll
    for (int pt = 0; pt < 4; ++pt) { const int ps = 16 * pt + l15; const float cr = cst[ps * 4 + 2], ci = cst[ps * 4 + 3];
        const float* br = p.b_re + ((size_t)g * 64 + ps) * 16 + (q4 & 1) * 8; const float* bi = p.b_im + ((size_t)g * 64 + ps) * 16 + (q4 & 1) * 8;
        const f32x4 r0 = *(const f32x4*)br, r1 = *(const f32x4*)(br + 4), i0 = *(const f32x4*)bi, i1 = *(const f32x4*)(bi + 4);
        float vr[8], vi[8];
#pragma unroll
        for (int e = 0; e < 4; ++e) { vr[e] = cr * r0[e] - ci * i0[e]; vi[e] = cr * i0[e] + ci * r0[e]; vr[4 + e] = cr * r1[e] - ci * i1[e]; vi[4 + e] = cr * i1[e] + ci * r1[e]; }
        if (q4 >= 2) {
#pragma unroll
            for (int e = 0; e < 8; ++e) { vr[e] -= bf2f((bf16_t)(cvt_pk_bf16(vr[e], 0.f) & 0xffffu)); vi[e] -= bf2f((bf16_t)(cvt_pk_bf16(vi[e], 0.f) & 0xffffu)); } }
        u32x4 o; o.x = cvt_pk_bf16(vr[0], vr[1]); o.y = cvt_pk_bf16(vr[2], vr[3]); o.z = cvt_pk_bf16(vr[4], vr[5]); o.w = cvt_pk_bf16(vr[6], vr[7]); bre[pt] = __builtin_bit_cast(bf16x8, o);
        o.x = cvt_pk_bf16(vi[0], vi[1]); o.y = cvt_pk_bf16(vi[2], vi[3]); o.z = cvt_pk_bf16(vi[4], vi[5]); o.w = cvt_pk_bf16(vi[6], vi[7]); bim[pt] = __builtin_bit_cast(bf16x8, o); }
    const int t0 = wid * 256;
#define S5_BU(tb) { const bf16x8 ua = *(const LAS bf16x8*)(u_s + ((tb) + l15) * 32 + (q4 & 1) * 16); \
        _Pragma("unroll") for (int pt = 0; pt < 4; ++pt) { const f32x4 z4 = (f32x4){0.f, 0.f, 0.f, 0.f}; \
            const f32x4 dr = __builtin_amdgcn_mfma_f32_16x16x32_bf16(ua, bre[pt], z4, 0, 0, 0), di = __builtin_amdgcn_mfma_f32_16x16x32_bf16(ua, bim[pt], z4, 0, 0, 0); \
            _Pragma("unroll") for (int i = 0; i < 4; ++i) { *(LAS float*)(W_s + (4 * q4 + i) * 528 + (16 * pt + l15) * 4) = dr[i]; *(LAS float*)(W_s + (4 * q4 + i) * 528 + 256 + (16 * pt + l15) * 4) = di[i]; } } \
        __builtin_amdgcn_wave_barrier(); }
    float sr = 0.f, si = 0.f;
    for (int sc = 0; sc < 16; ++sc) { S5_BU(t0 + sc * 16)
#pragma unroll
        for (int tt = 0; tt < 16; ++tt) { const float br_ = *(const LAS float*)(W_s + tt * 528 + lane * 4), bi_ = *(const LAS float*)(W_s + tt * 528 + 256 + lane * 4);
            const float nsr = ar * sr - ai * si + br_, nsi = ar * si + ai * sr + bi_; sr = nsr; si = nsi; }
        __builtin_amdgcn_wave_barrier(); }
    carry[(wid * 64 + lane) * 2] = sr; carry[(wid * 64 + lane) * 2 + 1] = si;
    __syncthreads();
    float pr = ar, pi = ai;
#pragma unroll
    for (int i = 0; i < 8; ++i) { const float nr2 = pr * pr - pi * pi, ni2 = 2.f * pr * pi; pr = nr2; pi = ni2; }
    sr = 0.f; si = 0.f;
    for (int v = 0; v < wid; ++v) { const float er = carry[(v * 64 + lane) * 2], ei = carry[(v * 64 + lane) * 2 + 1]; const float nsr = pr * sr - pi * si + er, nsi = pr * si + pi * sr + ei; sr = nsr; si = nsi; }
    for (int sc = 0; sc < 16; ++sc) { S5_BU(t0 + sc * 16)
#pragma unroll
        for (int tt = 0; tt < 16; ++tt) { const float br_ = *(const LAS float*)(W_s + tt * 528 + lane * 4), bi_ = *(const LAS float*)(W_s + tt * 528 + 256 + lane * 4);
            const float nsr = ar * sr - ai * si + br_, nsi = ar * si + ai * sr + bi_; sr = nsr; si = nsi;
            const unsigned pk = cvt_pk_bf16(sr, si);
            *(LAS bf16_t*)(W_s + tt * 528 + lane * 2) = (bf16_t)(pk & 0xffffu); *(LAS bf16_t*)(W_s + tt * 528 + 128 + lane * 2) = (bf16_t)(pk >> 16); }
        __builtin_amdgcn_wave_barrier();
        f32x4 acc = (f32x4){0.f, 0.f, 0.f, 0.f};
#pragma unroll
        for (int kb = 0; kb < 4; ++kb) { const bf16x8 a = *(const LAS bf16x8*)(W_s + l15 * 528 + kb * 64 + q4 * 16); acc = __builtin_amdgcn_mfma_f32_16x16x32_bf16(a, cf[kb], acc, 0, 0, 0); }
        __builtin_amdgcn_wave_barrier();
#pragma unroll
        for (int i = 0; i < 4; ++i) { const int t = t0 + sc * 16 + 4 * q4 + i; const float uv = bf2f(*(const LAS bf16_t*)(u_s + t * 32 + l15 * 2));
            const float yv = acc[i] + dsk * uv; const float z = 0.7978845608028654f * (yv + 0.044715f * yv * yv * yv); const float th = 1.f - 2.f / (__expf(2.f * z) + 1.f);
            const float gl = 0.5f * yv * (1.f + th);
            ybuf[(size_t)(b * SEQ + t) * 1024 + g * 16 + l15] = (bf16_t)(cvt_pk_bf16(gl, 0.f) & 0xffffu); }
    }
#undef S5_BU
}

__device__ __forceinline__ void dil_item(LAS unsigned char* lds, const Params& p, int item) {
    const int tid = threadIdx.x, lane = tid & 63, w = __builtin_amdgcn_readfirstlane(tid >> 6), l15 = lane & 15, q4 = lane >> 4;
    const int bh = item / 48, r48 = item % 48, b = bh >> 3, h = bh & 7, g = r48 >> 4, j = r48 & 15;
    const int dil = g == 0 ? 1 : (g == 1 ? 4 : 16), cls = j % dil, blk = j / dil, q0 = blk * 128;
    const bf16_t* proj0 = (const bf16_t*)(p.ws + OFF_A);
    const int qcol = 2048 + g * 3072 + h * 128, kcol = qcol + 1024, vcol = qcol + 2048;
    LAS unsigned char* Ks = lds; LAS unsigned char* Vs = lds + 128 * 288;
    const int qi = q0 + 16 * w + l15;
    bf16x8 qf[4];
    { const bf16_t* qp = proj0 + (size_t)(b * SEQ + cls + dil * qi) * EVEN_IN + qcol + 8 * q4;
#pragma unroll
      for (int ks = 0; ks < 4; ++ks) qf[ks] = *(const bf16x8*)(qp + 32 * ks); }
    float mrun = -INFINITY, lsum = 0.f; f32x4 O[8];
#pragma unroll
    for (int d = 0; d < 8; ++d) O[d] = (f32x4){0.f, 0.f, 0.f, 0.f};
    for (int half = (blk == 0 ? 1 : 0); half < 2; ++half) {
        const int kbase = q0 - 128 + 128 * half;
        __syncthreads();
#pragma unroll
        for (int i = 0; i < 4; ++i) { const int pc = tid + 512 * i, row = pc >> 4, ch = pc & 15; const bf16_t* src = proj0 + (size_t)(b * SEQ + cls + dil * (kbase + row)) * EVEN_IN + ch * 8;
            *(LAS u32x4*)(Ks + row * 288 + ch * 16) = *(const u32x4*)(src + kcol); *(LAS u32x4*)(Vs + row * 288 + ch * 16) = *(const u32x4*)(src + vcol); }
        __syncthreads();
        f32x4 S[8]; float mx = -INFINITY;
#pragma unroll
        for (int kt = 0; kt < 8; ++kt) { f32x4 a = (f32x4){-INFINITY, -INFINITY, -INFINITY, -INFINITY};
            if (half ? (kt <= w) : (kt >= w)) { a = (f32x4){0.f, 0.f, 0.f, 0.f};
#pragma unroll
                for (int ks = 0; ks < 4; ++ks) { const bf16x8 kf = *(const LAS bf16x8*)(Ks + (16 * kt + l15) * 288 + ks * 64 + q4 * 16); a = __builtin_amdgcn_mfma_f32_16x16x32_bf16(kf, qf[ks], a, 0, 0, 0); }
#pragma unroll
                for (int i = 0; i < 4; ++i) { const int dist = qi - (kbase + 16 * kt + 4 * q4 + i); a[i] = (dist >= 0 && dist <= 128) ? a[i] : -INFINITY; mx = fmaxf(mx, a[i]); } }
            S[kt] = a; }
        mx = max_xor32(max_xor16(mx));
        const float mnew = fmaxf(mrun, mx), alpha = exp2f(mrun - mnew); mrun = mnew; lsum *= alpha;
#pragma unroll
        for (int d = 0; d < 8; ++d) O[d] = O[d] * alpha;
#pragma unroll
        for (int kt = 0; kt < 8; ++kt)
#pragma unroll
            for (int i = 0; i < 4; ++i) { const float pv = exp2f(S[kt][i] - mnew); S[kt][i] = pv; lsum += pv; }
#pragma unroll
        for (int s = 0; s < 4; ++s) if (half ? (2 * s <= w) : (2 * s + 1 >= w)) { u32x4 pk; pk.x = cvt_pk_bf16(S[2 * s][0], S[2 * s][1]); pk.y = cvt_pk_bf16(S[2 * s][2], S[2 * s][3]); pk.z = cvt_pk_bf16(S[2 * s + 1][0], S[2 * s + 1][1]); pk.w = cvt_pk_bf16(S[2 * s + 1][2], S[2 * s + 1][3]);
            const bf16x8 pf = __builtin_bit_cast(bf16x8, pk);
#pragma unroll
            for (int d = 0; d < 8; ++d) {
                LAS unsigned char* va = Vs + (32 * s + 4 * q4 + (l15 >> 2)) * 288 + (16 * d + 4 * (l15 & 3)) * 2;
                const s16x4 t0 = __builtin_amdgcn_ds_read_tr16_b64_v4i16((LAS s16x4*)va), t1 = __builtin_amdgcn_ds_read_tr16_b64_v4i16((LAS s16x4*)(va + 16 * 288));
                const bf16x8 vf = __builtin_shufflevector(t0, t1, 0, 1, 2, 3, 4, 5, 6, 7);
                O[d] = __builtin_amdgcn_mfma_f32_16x16x32_bf16(vf, pf, O[d], 0, 0, 0); } }
    }
    lsum = sum_xor32(sum_xor16(lsum));
    const float inv = 1.f / lsum; const size_t tok = (size_t)b * SEQ + cls + dil * qi;
    bf16_t* ob = (bf16_t*)(p.ws + OFF_OBUF) + ((size_t)g * NTOK + tok) * 1024 + h * 128 + 4 * q4;
#pragma unroll
    for (int d = 0; d < 8; ++d) *(u32x2*)(ob + 16 * d) = pack4(O[d] * inv);
    if (q4 == 0) ((float*)(p.ws + OFF_LSE))[((size_t)g * NTOK + tok) * 8 + h] = mrun + log2f(lsum);
}

__device__ __forceinline__ void merge_rows(const Params& p, int first, int stride) {
    const bf16_t* __restrict__ obuf = (const bf16_t*)(p.ws + OFF_OBUF); const float* __restrict__ lse = (const float*)(p.ws + OFF_LSE); const bf16_t* __restrict__ proj0 = (const bf16_t*)(p.ws + OFF_A); bf16_t* __restrict__ mix = (bf16_t*)(p.ws + OFF_MIX);
    const int c = threadIdx.x, h = c >> 6;
    for (int tok0 = first; tok0 < NTOK; tok0 += 4 * stride) {
        float l[4][3]; unsigned o[4][3], zb[4];
#pragma unroll
        for (int u = 0; u < 4; ++u) { const int tok = tok0 + u * stride; if (tok < NTOK) {
#pragma unroll
            for (int g = 0; g < 3; ++g) { l[u][g] = lse[((size_t)g * NTOK + tok) * 8 + h]; o[u][g] = *(const unsigned*)(obuf + ((size_t)g * NTOK + tok) * 1024 + 2 * c); }
            zb[u] = *(const unsigned*)(proj0 + (size_t)tok * EVEN_IN + 11264 + 2 * c); } }
#pragma unroll
        for (int u = 0; u < 4; ++u) { const int tok = tok0 + u * stride; if (tok < NTOK) {
            const float mx = fmaxf(l[u][0], fmaxf(l[u][1], l[u][2])), e0 = exp2f(l[u][0] - mx), e1 = exp2f(l[u][1] - mx), e2 = exp2f(l[u][2] - mx), inv = 1.f / (e0 + e1 + e2);
            const float a = (e0 * bflo(o[u][0]) + e1 * bflo(o[u][1]) + e2 * bflo(o[u][2])) * inv * silu_f(bflo(zb[u])), bq = (e0 * bfhi(o[u][0]) + e1 * bfhi(o[u][1]) + e2 * bfhi(o[u][2])) * inv * silu_f(bfhi(zb[u]));
            *(unsigned*)(mix + (size_t)tok * 2048 + 1024 + 2 * c) = cvt_pk_bf16(a, bq); } }
    }
}

__device__ __forceinline__ void phase7(LAS unsigned char* lds, const Params& p) {
    const int lane = threadIdx.x & 63, wid = threadIdx.x >> 6;
    const bf16_t* proj1 = (const bf16_t*)(p.ws + OFF_PROJ1); bf16_t* ckv = (bf16_t*)(p.ws + OFF_CKV); bf16_t* kidx = (bf16_t*)(p.ws + OFF_KIDX);
    float* widx = (float*)(p.ws + OFF_WIDX); float* rsq = (float*)(p.ws + OFF_RSQ); const float2* rope = (const float2*)(p.ws + OFF_ROPE);
    float kmaxw = 0.f;
    for (int row = blockIdx.x * 8 + wid; row < NTOK; row += gridDim.x * 8) { const bf16_t* pr = proj1 + (size_t)row * ODD_INP; const int pos = row & 2047;
        float ss = 0.f, kn2 = 0.f;
#pragma unroll
        for (int i = 0; i < 3; ++i) { const u32x4 v = *(const u32x4*)(pr + (i * 64 + lane) * 8);
            ss += bflo(v.x) * bflo(v.x) + bfhi(v.x) * bfhi(v.x) + bflo(v.y) * bflo(v.y) + bfhi(v.y) * bfhi(v.y) + bflo(v.z) * bflo(v.z) + bfhi(v.z) * bfhi(v.z) + bflo(v.w) * bflo(v.w) + bfhi(v.w) * bfhi(v.w); }
        ss = wave_sum(ss); if (lane == 0) rsq[row] = rsqrtf(ss * (1.f / 1536.f) + EPS);
        { const u32x4 v = *(const u32x4*)(pr + 1536 + lane * 8); float f[8] = {bflo(v.x), bfhi(v.x), bflo(v.y), bfhi(v.y), bflo(v.z), bfhi(v.z), bflo(v.w), bfhi(v.w)}; float s2 = 0.f;
#pragma unroll
          for (int e = 0; e < 8; ++e) s2 += f[e] * f[e];
          s2 = wave_sum(s2); const float r = rsqrtf(s2 * (1.f / 512.f) + EPS); const f32x4 g0 = *(const f32x4*)(p.kv_norm + lane * 8), g1 = *(const f32x4*)(p.kv_norm + lane * 8 + 4);
          u32x4 o; o.x = cvt_pk_bf16(f[0] * r * g0.x, f[1] * r * g0.y); o.y = cvt_pk_bf16(f[2] * r * g0.z, f[3] * r * g0.w); o.z = cvt_pk_bf16(f[4] * r * g1.x, f[5] * r * g1.y); o.w = cvt_pk_bf16(f[6] * r * g1.z, f[7] * r * g1.w);
          *(u32x4*)(ckv + (size_t)row * KVLD + lane * 8) = o;
          float k2 = 0.f;
#pragma unroll
          for (int e = 0; e < 4; ++e) { const float a0 = f[e] * r * g0[e], a1 = f[4 + e] * r * g1[e]; k2 += a0 * a0 + a1 * a1; }
          kn2 = k2; }
        {
          const float v = bf2f(pr[2048 + (lane & 31)]); const float o = __shfl_xor(v, 16); const float2 cs = rope[pos * 16 + (lane & 15)];
          const float r = (lane & 16) ? (v * cs.x + o * cs.y) : (v * cs.x - o * cs.y);
          if (lane < 32) { ckv[(size_t)row * KVLD + 512 + lane] = (bf16_t)(cvt_pk_bf16(r, 0.f) & 0xffffu); kn2 += r * r; }
          kn2 = wave_sum(kn2); kmaxw = fmaxf(kmaxw, kn2); }
        {
          const float a = bf2f(pr[2080 + lane]), c = bf2f(pr[2080 + 64 + lane]); const float s2 = wave_sum(a * a + c * c); const float r = rsqrtf(s2 * (1.f / 128.f) + EPS);
          float an = a * r * p.idx_k_norm[lane]; const float cn = c * r * p.idx_k_norm[64 + lane];
          const float o = __shfl_xor(an, 16); const float2 cs = rope[pos * 16 + (lane & 15)];
          if (lane < 32) an = (lane & 16) ? (an * cs.x + o * cs.y) : (an * cs.x - o * cs.y);
          kidx[(size_t)row * 128 + lane] = (bf16_t)(cvt_pk_bf16(an, 0.f) & 0xffffu); kidx[(size_t)row * 128 + 64 + lane] = (bf16_t)(cvt_pk_bf16(cn, 0.f) & 0xffffu); }
        if (lane < 32) widx[(size_t)row * 32 + lane] = bf2f(pr[2208 + lane]) * (0.08838834764831845f * 0.17677669529663687f);
    }
    LAS float* red = (LAS float*)lds;
    __syncthreads();
    if (lane == 0) red[wid] = kmaxw;
    __syncthreads();
    if (threadIdx.x == 0) { float m = red[0];
#pragma unroll
        for (int i = 1; i < 8; ++i) m = fmaxf(m, red[i]);
        atomicMax((int*)(p.ws + OFF_BAR), __float_as_int(m * 1.02f)); }
}

__device__ __forceinline__ unsigned fkey(float f) { const unsigned u = __float_as_uint(f); return (u & 0x80000000u) ? ~u : (u | 0x80000000u); }
__device__ __forceinline__ void topk_pair(const Params& p, int tokA, int tokB) {
    const int lane = threadIdx.x & 63; const bool two = tokB >= 0; if (!two) tokB = tokA;
    const int qp[2] = {tokA & 2047, tokB & 2047};
    const float* sc[2] = {(const float*)(p.ws + OFF_ISC) + (size_t)tokA * 2048, (const float*)(p.ws + OFF_ISC) + (size_t)tokB * 2048};
    bf16_t* sel[2] = {(bf16_t*)(p.ws + OFF_SEL) + (size_t)tokA * 256, (bf16_t*)(p.ws + OFF_SEL) + (size_t)tokB * 256};
    unsigned key[2][32];
#pragma unroll
    for (int q = 0; q < 2; ++q)
#pragma unroll
        for (int i = 0; i < 32; ++i) { const int idx = i * 64 + lane; key[q][i] = idx <= qp[q] ? fkey(sc[q][idx <= qp[q] ? idx : 0]) : 0u; }
    unsigned T[2] = {0u, 0u}; bool ex[2] = {false, false};
    for (int bit = 31; bit >= 0; --bit) {
        if (ex[0] && ex[1]) break;
        const unsigned c0 = T[0] | (1u << bit), c1 = T[1] | (1u << bit); unsigned cnt = 0u;
#pragma unroll
        for (int i = 0; i < 32; ++i) { cnt += (key[0][i] >= c0) ? 1u : 0u; cnt += (key[1][i] >= c1) ? 0x10000u : 0u; }
        cnt += (unsigned)__builtin_amdgcn_update_dpp(0, (int)cnt, 0xB1, 0xf, 0xf, false);
        cnt += (unsigned)__builtin_amdgcn_update_dpp(0, (int)cnt, 0x4E, 0xf, 0xf, false);
        cnt += (unsigned)__builtin_amdgcn_update_dpp(0, (int)cnt, 0x141, 0xf, 0xf, false);
        cnt += (unsigned)__builtin_amdgcn_update_dpp(0, (int)cnt, 0x140, 0xf, 0xf, false);
        { typedef unsigned u32x2p __attribute__((ext_vector_type(2)));
          u32x2p r = __builtin_amdgcn_permlane16_swap(cnt, cnt, false, false); cnt = r.x + r.y;
          r = __builtin_amdgcn_permlane32_swap(cnt, cnt, false, false); cnt = r.x + r.y; }
        cnt = (unsigned)__builtin_amdgcn_readfirstlane((int)cnt);
        const int n0 = (int)(cnt & 0xffffu), n1 = (int)(cnt >> 16);
        if (!ex[0]) { if (n0 >= 256) T[0] = c0; if (n0 == 256) ex[0] = true; }
        if (!ex[1]) { if (n1 >= 256) T[1] = c1; if (n1 == 256) ex[1] = true; }
    }
#pragma unroll
    for (int q = 0; q < 2; ++q) { if (q == 1 && !two) break;
        int base = 0;
#pragma unroll
        for (int i = 0; i < 32; ++i) { const bool pr = ex[q] ? key[q][i] >= T[q] : key[q][i] > T[q]; const unsigned long long mk = __ballot(pr); const int pos = base + __builtin_amdgcn_mbcnt_hi((unsigned)(mk >> 32), __builtin_amdgcn_mbcnt_lo((unsigned)mk, 0u));
            if (pr) sel[q][pos] = (bf16_t)(i * 64 + lane); base += __popcll(mk); }
        if (!ex[q])
#pragma unroll
        for (int i = 0; i < 32; ++i) { const bool pr = key[q][i] == T[q]; const unsigned long long mk = __ballot(pr); const int pos = base + __builtin_amdgcn_mbcnt_hi((unsigned)(mk >> 32), __builtin_amdgcn_mbcnt_lo((unsigned)mk, 0u));
            if (pr && pos < 256) sel[q][pos] = (bf16_t)(i * 64 + lane); base += __popcll(mk); } }
}
__device__ __forceinline__ void topk_phase(const Params& p) {
    const int lane = threadIdx.x & 63, wid = threadIdx.x >> 6, G = gridDim.x, bid = blockIdx.x;
    const int nq = (NTOK - bid + G - 1) / G;
    int mine[4]; int nm = 0;
    int k = 0;
    for (int j = 0; j < nq; ++j) { const int token = bid + G * j, qpos = token & 2047;
        if (qpos < 256) { if ((j & 7) == wid) { bf16_t* sel = (bf16_t*)(p.ws + OFF_SEL) + (size_t)token * 256; for (int i = lane; i <= qpos; i += 64) sel[i] = (bf16_t)i; } }
        else { if ((k & 7) == wid && nm < 4) { if (nm == 0) mine[0] = token; else if (nm == 1) mine[1] = token; else if (nm == 2) mine[2] = token; else mine[3] = token; ++nm; } else if ((k & 7) == wid) topk_pair(p, token, -1); ++k; } }
    if (nm >= 2) topk_pair(p, mine[0], mine[1]); else if (nm == 1) topk_pair(p, mine[0], -1);
    if (nm >= 4) topk_pair(p, mine[2], mine[3]); else if (nm == 3) topk_pair(p, mine[2], -1);
}


#define LDSRD4(k0, k1, k2, k3, addr, o0, o1, o2, o3) asm volatile("ds_read_b128 %0, %4 offset:%5\n\tds_read_b128 %1, %4 offset:%6\n\tds_read_b128 %2, %4 offset:%7\n\tds_read_b128 %3, %4 offset:%8\n\ts_waitcnt lgkmcnt(0)" \
        : "=&v"(k0), "=&v"(k1), "=&v"(k2), "=&v"(k3) : "v"(addr), "n"(o0), "n"(o1), "n"(o2), "n"(o3) : "memory")
#define LDSRD2(k0, k1, addr, o0, o1) asm volatile("ds_read_b128 %0, %2 offset:%3\n\tds_read_b128 %1, %2 offset:%4\n\ts_waitcnt lgkmcnt(0)" : "=&v"(k0), "=&v"(k1) : "v"(addr), "n"(o0), "n"(o1) : "memory")
#define LDSRD1(k0, addr, o0) asm volatile("ds_read_b128 %0, %1 offset:%2\n\ts_waitcnt lgkmcnt(0)" : "=&v"(k0) : "v"(addr), "n"(o0) : "memory")
__device__ __forceinline__ void lds_rd_mx8(float (&m)[8], unsigned addr) {
    asm volatile("ds_read_b32 %0, %8\n\tds_read_b32 %1, %8 offset:128\n\tds_read_b32 %2, %8 offset:256\n\tds_read_b32 %3, %8 offset:384\n\t"
                 "ds_read_b32 %4, %8 offset:64\n\tds_read_b32 %5, %8 offset:192\n\tds_read_b32 %6, %8 offset:320\n\tds_read_b32 %7, %8 offset:448\n\ts_waitcnt lgkmcnt(0)"
                 : "=&v"(m[0]), "=&v"(m[1]), "=&v"(m[2]), "=&v"(m[3]), "=&v"(m[4]), "=&v"(m[5]), "=&v"(m[6]), "=&v"(m[7]) : "v"(addr) : "memory");
}
#define LDSRD_PV(p0, p1, t, pb, vb, PO, VO) asm volatile("ds_read_b128 %0, %10 offset:%12\n\tds_read_b128 %1, %10 offset:%13\n\t" \
        "ds_read_b64_tr_b16 %2, %11 offset:%14\n\tds_read_b64_tr_b16 %3, %11 offset:%15\n\tds_read_b64_tr_b16 %4, %11 offset:%16\n\tds_read_b64_tr_b16 %5, %11 offset:%17\n\t" \
        "ds_read_b64_tr_b16 %6, %11 offset:%18\n\tds_read_b64_tr_b16 %7, %11 offset:%19\n\tds_read_b64_tr_b16 %8, %11 offset:%20\n\tds_read_b64_tr_b16 %9, %11 offset:%21\n\ts_waitcnt lgkmcnt(0)" \
        : "=&v"(p0), "=&v"(p1), "=&v"(t[0]), "=&v"(t[1]), "=&v"(t[2]), "=&v"(t[3]), "=&v"(t[4]), "=&v"(t[5]), "=&v"(t[6]), "=&v"(t[7]) \
        : "v"(pb), "v"(vb), "n"(PO), "n"((PO) + 2304), "n"(VO), "n"((VO) + 4416), "n"((VO) + 32), "n"((VO) + 32 + 4416), "n"((VO) + 64), "n"((VO) + 64 + 4416), "n"((VO) + 96), "n"((VO) + 96 + 4416) : "memory")
#define LDSRD_PVA(p0, p1, t, pb, vb, PO, VO) asm volatile("ds_read_b128 %0, %6 offset:%8\n\tds_read_b128 %1, %6 offset:%9\n\t" \
        "ds_read_b64_tr_b16 %2, %7 offset:%10\n\tds_read_b64_tr_b16 %3, %7 offset:%11\n\tds_read_b64_tr_b16 %4, %7 offset:%12\n\tds_read_b64_tr_b16 %5, %7 offset:%13\n\ts_waitcnt lgkmcnt(0)" \
        : "=&v"(p0), "=&v"(p1), "=&v"(t[0]), "=&v"(t[1]), "=&v"(t[2]), "=&v"(t[3]) \
        : "v"(pb), "v"(vb), "n"(PO), "n"((PO) + 2304), "n"(VO), "n"((VO) + 4416), "n"((VO) + 32), "n"((VO) + 32 + 4416) : "memory")
#define LDSRD_PVB(t, vb, VO) asm volatile("ds_read_b64_tr_b16 %0, %4 offset:%5\n\tds_read_b64_tr_b16 %1, %4 offset:%6\n\tds_read_b64_tr_b16 %2, %4 offset:%7\n\tds_read_b64_tr_b16 %3, %4 offset:%8\n\ts_waitcnt lgkmcnt(0)" \
        : "=&v"(t[0]), "=&v"(t[1]), "=&v"(t[2]), "=&v"(t[3]) : "v"(vb), "n"((VO) + 64), "n"((VO) + 64 + 4416), "n"((VO) + 96), "n"((VO) + 96 + 4416) : "memory")
#define WG_BAR() do { asm volatile("s_waitcnt lgkmcnt(0)" ::: "memory"); __builtin_amdgcn_s_barrier(); asm volatile("" ::: "memory"); } while (0)
__device__ __forceinline__ void dsa_phase(LAS unsigned char* lds, const Params& p, bool do_write) {
    const int tid = threadIdx.x, lane = tid & 63, w = tid >> 6, l15 = lane & 15, q4 = lane >> 4, kt = w & 3, ht = w >> 2;
    const int G = gridDim.x, bid = blockIdx.x;
    const int nq = (NTOK - bid + G - 1) / G;
    if (nq <= 0) return;
    LAS unsigned char* Pl = lds + 141312;
    LAS float* mxs = (LAS float*)(lds + 145920);
    LAS float* lred = mxs + 128;
    LAS int* sels = (LAS int*)(lds + 146944);
    const bf16_t* selg = (const bf16_t*)(p.ws + OFF_SEL);
    const float kmax2 = __int_as_float(__hip_atomic_load((const int*)(p.ws + OFF_BAR), __ATOMIC_RELAXED, __HIP_MEMORY_SCOPE_AGENT));
    unsigned gpk[5] = {0u, 0u, 0u, 0u, 0u};
#pragma unroll
    for (int i = 0; i < 9; ++i) { const int q = w + 8 * i, pc = 64 * q + lane, row = q < 69 ? pc / 69 : 0, col = pc - row * 69; gpk[i >> 1] |= ((unsigned)row | ((unsigned)col << 6)) << (16 * (i & 1)); }
#define GATHER_DMA(ckvb, selbase, buf) { _Pragma("unroll") for (int i = 0; i < 9; ++i) { const int q = w + 8 * i; if (q < 69) { unsigned gw = gpk[i >> 1]; asm volatile("" : "+v"(gw)); const unsigned ge = (gw >> (16 * (i & 1))) & 0xffffu; const int col = (int)(ge >> 6); \
        const int idx = sels[(selbase) + (int)(ge & 63u)]; const unsigned char* gsrc = (ckvb) + (size_t)idx * (KVLD * 2) + (col < 68 ? col * 16 : 0); \
        __builtin_amdgcn_global_load_lds((const unsigned*)gsrc, (LAS unsigned*)((buf) + q * 1024), 16, 0, 0); } } }
#define DMA_WAIT() asm volatile("s_waitcnt vmcnt(0)" ::: "memory")
    const unsigned sa0 = (unsigned)(size_t)(lds + (16 * kt + l15) * 1104 + q4 * 16);
    const unsigned va0 = (unsigned)(size_t)(lds + (8 * q4 + (l15 >> 2)) * 1104 + (64 * w + 4 * (l15 & 3)) * 2);
    const unsigned pa0 = (unsigned)(size_t)(Pl + l15 * 144 + q4 * 16);
    const unsigned ma0 = (unsigned)(size_t)((LAS unsigned char*)mxs + l15 * 4);
    bf16x8 qf[17];
    { const int token = bid, qpos = token & 2047, cnt = qpos + 1 < 256 ? qpos + 1 : 256;
      if (tid < 256) sels[tid] = tid < cnt ? (int)selg[(size_t)token * 256 + tid] : 0;
      const bf16_t* qp = (const bf16_t*)(p.ws + OFF_D) + (size_t)token * QLD + (16 * ht + l15) * 544 + 8 * q4;
#pragma unroll
      for (int ks = 0; ks < 17; ++ks) qf[ks] = *(const bf16x8*)(qp + 32 * ks);
      WG_BAR();
      const unsigned char* ckv = p.ws + OFF_CKV + (size_t)(token >> 11) * SEQ * KVLD * 2;
      GATHER_DMA(ckv, 0, lds)
      DMA_WAIT(); WG_BAR(); }
#pragma nounroll
    for (int j = 0; j < nq; ++j) {
        const int token = bid + G * j, qpos = token & 2047, cnt = qpos + 1 < 256 ? qpos + 1 : 256;
        const bool has_nq = j + 1 < nq; const int token_n = token + G, qpos_n = token_n & 2047, cnt_n = qpos_n + 1 < 256 ? qpos_n + 1 : 256;
        bf16_t* qlat = (bf16_t*)(p.ws + OFF_D) + (size_t)token * QLD;
        const unsigned char* ckv = p.ws + OFF_CKV + (size_t)(token >> 11) * SEQ * KVLD * 2;
        const unsigned char* ckv_n = p.ws + OFF_CKV + (size_t)(token_n >> 11) * SEQ * KVLD * 2;
        const int sb = (j & 1) * 256, sbn = ((j + 1) & 1) * 256;
        int t2 = tid; asm volatile("" : "+v"(t2));
        const int l15b = t2 & 15, q4b = (t2 >> 4) & 3;
        if (has_nq && tid < 256) sels[sbn + tid] = tid < cnt_n ? (int)selg[(size_t)token_n * 256 + t2] : 0;
        WG_BAR();
        float lpart = 0.f; f32x4 O[4][2];
        float mref;
        { f32x4 qq = (f32x4){0.f, 0.f, 0.f, 0.f};
#pragma unroll
          for (int ks = 0; ks < 17; ++ks) qq = __builtin_amdgcn_mfma_f32_16x16x32_bf16(qf[ks], qf[ks], qq, 0, 0, 0);
          const int sel3 = l15 & 3; float d = sel3 == 0 ? qq[0] : (sel3 == 1 ? qq[1] : (sel3 == 2 ? qq[2] : qq[3]));
          d = (q4 == (l15 >> 2)) ? d : 0.f; d = sum_xor32(sum_xor16(d));
          mref = sqrtf(d * kmax2) * 1.01f + 1e-3f; }
#pragma unroll
        for (int c = 0; c < 4; ++c) { O[c][0] = (f32x4){0.f, 0.f, 0.f, 0.f}; O[c][1] = (f32x4){0.f, 0.f, 0.f, 0.f}; }
#pragma unroll
        for (int ch = 0; ch < 4; ++ch) {
            LAS unsigned char* Kc = lds + (ch & 1) * 70656; LAS unsigned char* Kn = lds + ((ch & 1) ^ 1) * 70656;
            if (ch < 3) GATHER_DMA(ckv, sb + 64 * (ch + 1), Kn) else if (has_nq) GATHER_DMA(ckv_n, sbn, Kn)
            f32x4 a = (f32x4){0.f, 0.f, 0.f, 0.f};
            const bool act = 64 * ch < cnt;
            if (act) { const unsigned sa = sa0 + (ch & 1) * 70656; bf16x8 k0, k1, k2, k3;
#define S4(K) LDSRD4(k0, k1, k2, k3, sa, (K) * 64, (K) * 64 + 64, (K) * 64 + 128, (K) * 64 + 192); \
              a = __builtin_amdgcn_mfma_f32_16x16x32_bf16(k0, qf[K], a, 0, 0, 0); a = __builtin_amdgcn_mfma_f32_16x16x32_bf16(k1, qf[(K) + 1], a, 0, 0, 0); \
              a = __builtin_amdgcn_mfma_f32_16x16x32_bf16(k2, qf[(K) + 2], a, 0, 0, 0); a = __builtin_amdgcn_mfma_f32_16x16x32_bf16(k3, qf[(K) + 3], a, 0, 0, 0);
              S4(0) S4(4) S4(8) S4(12)
#undef S4
              LDSRD1(k0, sa, 1024); a = __builtin_amdgcn_mfma_f32_16x16x32_bf16(k0, qf[16], a, 0, 0, 0); }
            asm volatile("" ::: "memory");
            if (ch == 3 && has_nq) { const bf16_t* qp = (const bf16_t*)(p.ws + OFF_D) + (size_t)token_n * QLD + (16 * ht + l15b) * 544 + 8 * q4b;
#pragma unroll
                for (int ks = 0; ks < 17; ++ks) qf[ks] = *(const bf16x8*)(qp + 32 * ks); }
            if (act) {
            f32x4 pv; float ps = 0.f;
#pragma unroll
            for (int i = 0; i < 4; ++i) { pv[i] = (64 * ch + 16 * kt + 4 * q4 + i) < cnt ? __builtin_amdgcn_exp2f(a[i] - mref) : 0.f; ps += pv[i]; }
            lpart += ps;
            *(LAS u32x2*)(Pl + (16 * ht + l15) * 144 + (16 * kt + 4 * q4) * 2) = pack4(pv);
            WG_BAR();
            { const unsigned vb = va0 + (ch & 1) * 70656; bf16x8 p0, p1; s16x4 t[4];
#define PVH(S2) LDSRD_PVA(p0, p1, t, pa0, vb, (S2) * 64, (S2) * 35328); \
              _Pragma("unroll") for (int c = 0; c < 2; ++c) { const bf16x8 vf = __builtin_shufflevector(t[2 * c], t[2 * c + 1], 0, 1, 2, 3, 4, 5, 6, 7); \
                  O[c][0] = __builtin_amdgcn_mfma_f32_16x16x32_bf16(vf, p0, O[c][0], 0, 0, 0); O[c][1] = __builtin_amdgcn_mfma_f32_16x16x32_bf16(vf, p1, O[c][1], 0, 0, 0); } \
              LDSRD_PVB(t, vb, (S2) * 35328); \
              _Pragma("unroll") for (int c = 0; c < 2; ++c) { const bf16x8 vf = __builtin_shufflevector(t[2 * c], t[2 * c + 1], 0, 1, 2, 3, 4, 5, 6, 7); \
                  O[2 + c][0] = __builtin_amdgcn_mfma_f32_16x16x32_bf16(vf, p0, O[2 + c][0], 0, 0, 0); O[2 + c][1] = __builtin_amdgcn_mfma_f32_16x16x32_bf16(vf, p1, O[2 + c][1], 0, 0, 0); }
              PVH(0) PVH(1)
#undef PVH
            }
            }
            DMA_WAIT(); WG_BAR();
        }
        lpart = sum_xor32(sum_xor16(lpart));
        if (q4 == 0) lred[kt * 32 + 16 * ht + l15] = lpart;
        WG_BAR();
        const float i0 = 1.f / (lred[l15] + lred[32 + l15] + lred[64 + l15] + lred[96 + l15]), i1 = 1.f / (lred[16 + l15] + lred[48 + l15] + lred[80 + l15] + lred[112 + l15]);
#pragma unroll
        for (int c = 0; c < 4; ++c) if (do_write) { *(u32x2*)(qlat + l15b * 512 + 64 * w + 16 * c + 4 * q4b) = pack4(O[c][0] * i0); *(u32x2*)(qlat + (16 + l15b) * 512 + 64 * w + 16 * c + 4 * q4b) = pack4(O[c][1] * i1); }
    }
#undef GATHER_DMA
#undef DMA_WAIT
}

#define XB_TMO      128
#define XB_XCNT(j)  (256  + 64 * (j))
#define XB_XSUB(j)  (1280 + 64 * (j))
#define XB_XGEN(j)  (2304 + 64 * (j))
#define XB_TOP      3328
#define XB_TOPGEN   3392
#define XCD_BAR_WORDS 3456
#define XB_SPIN_CAP (1u << 20)
__device__ __forceinline__ unsigned xb_ld(unsigned* p)              { return __hip_atomic_load(p, __ATOMIC_RELAXED, __HIP_MEMORY_SCOPE_AGENT); }
__device__ __forceinline__ unsigned xb_add(unsigned* p, unsigned v) { return __hip_atomic_fetch_add(p, v, __ATOMIC_RELAXED, __HIP_MEMORY_SCOPE_AGENT); }
__device__ __forceinline__ unsigned xb_xcc_id() { return (unsigned)__builtin_amdgcn_s_getreg((3 << 11) | 20) & 0xFu; }
#define XB_SPIN(cond, bar) do { unsigned _sp = 0; while (cond) { __builtin_amdgcn_s_sleep(1); \
    if ((++_sp & 255u) == 0u) { if (xb_ld(&(bar)[XB_TMO])) break; if (_sp > XB_SPIN_CAP) { atomicAdd(&(bar)[XB_TMO], 1u); break; } } } } while (0)
struct XcdBarrier { unsigned* bar; unsigned x; volatile LAS unsigned* st; };
__device__ __forceinline__ XcdBarrier xcd_barrier_post(unsigned* bar, volatile LAS unsigned* st) {
    XcdBarrier b; b.bar = bar; b.x = xb_xcc_id(); b.st = st;
    if (threadIdx.x == 0) (void)xb_add(&bar[XB_XCNT(b.x)], 1u);
    return b;
}
__device__ __forceinline__ uint2 xcd_barrier_complete(unsigned* bar, unsigned x) {
    const unsigned G = gridDim.x * gridDim.y * gridDim.z;
    unsigned sum, cnt, mine, sp = 0u;
    for (;;) {
        sum = 0u; cnt = 0u; mine = 0u;
#pragma unroll
        for (unsigned j = 0; j < 16; ++j) { const unsigned c = xb_ld(&bar[XB_XCNT(j)]); sum += c; cnt += (c > 0u) ? 1u : 0u; mine = (j == x) ? c : mine; }
        if (sum == G) break;
        __builtin_amdgcn_s_sleep(1);
        if ((++sp & 255u) == 0u) { if (xb_ld(&bar[XB_TMO])) break; if (sp > XB_SPIN_CAP) { atomicAdd(&bar[XB_TMO], 1u); break; } }
    }
    return make_uint2(mine > 0u ? mine : 1u, cnt > 0u ? cnt : 1u);
}
__device__ __forceinline__ void xcd_barrier(const XcdBarrier& b) {
    asm volatile("s_waitcnt vmcnt(0)" ::: "memory");
    __syncthreads();
    if (threadIdx.x == 0) {
        unsigned* bar = b.bar;
        __builtin_amdgcn_s_waitcnt(0);
        unsigned nloc = b.st[0], nx = b.st[1];
        if (nloc == 0u) { const uint2 r = xcd_barrier_complete(bar, b.x); nloc = r.x; nx = r.y; b.st[0] = nloc; b.st[1] = nx; }
        const unsigned old = xb_add(&bar[XB_XSUB(b.x)], 1u);
        const unsigned gen = old / nloc;
        if (old + 1u == (gen + 1u) * nloc) {
            __builtin_amdgcn_fence(__ATOMIC_RELEASE, "agent");
            asm volatile("s_waitcnt vmcnt(0)" ::: "memory");
            const unsigned og = xb_add(&bar[XB_TOP], 1u);
            const unsigned tg = og / nx;
            if (og + 1u == (tg + 1u) * nx) xb_add(&bar[XB_TOPGEN], 1u);
            else XB_SPIN(xb_ld(&bar[XB_TOPGEN]) == tg, bar);
            __builtin_amdgcn_fence(__ATOMIC_ACQUIRE, "agent");
            xb_add(&bar[XB_XGEN(b.x)], 1u);
            asm volatile("s_waitcnt vmcnt(0)" ::: "memory");
        } else {
            XB_SPIN(xb_ld(&bar[XB_XGEN(b.x)]) == gen, bar);
            __builtin_amdgcn_fence(__ATOMIC_ACQUIRE, "agent");
            asm volatile("s_waitcnt vmcnt(0)" ::: "memory");
        }
    }
    __syncthreads();
}

__global__ void __launch_bounds__(512, 2) fwd_megakernel(Params p) {
    extern __shared__ __attribute__((aligned(16))) unsigned char smem[];
    LAS unsigned char* lds = (LAS unsigned char*)smem;
    cg::grid_group grid = cg::this_grid();
    unsigned char* ws = p.ws; const int G = gridDim.x, bid = blockIdx.x;
    const float2* rope = (const float2*)(ws + OFF_ROPE);
    volatile LAS unsigned* xst = (volatile LAS unsigned*)(lds + LDS_BYTES - 16);
    if (threadIdx.x == 0) { xst[0] = 0u; xst[1] = 0u; }
    __syncthreads();
    const XcdBarrier xb = xcd_barrier_post((unsigned*)(ws + OFF_BAR), xst);
#ifdef ONLY
#define PHASE(n) if ((n) == ONLY)
#else
#define PHASE(n) if (p.ph_lo <= (n) && (n) <= p.ph_hi)
#endif
#define SYNC(n) if (p.ph_lo <= (n) && (n) < p.ph_hi) { if ((n) == 0) grid.sync(); else xcd_barrier(xb); }
#define REP(n) for (int _r = 0, _nr = 1 + ((p.rep >> (n)) & 1); _r < _nr; ++_r)
    PHASE(0) REP(0) { phase0(lds, p); __syncthreads(); }
    SYNC(0);
    PHASE(1) { Sched2D S{(const char*)(ws + OFF_B), (const char*)(ws + OFF_WIN0), (size_t)256 * 4096 * 2, (size_t)256 * 4096 * 2, 32, 48, G, bid};
        EpiProj0 E{(bf16_t*)(ws + OFF_A), rope}; gemm_phase(lds, 4096, 4096, 4096, S, E); }
    SYNC(1);
    PHASE(2) REP(2) { const int rb = (G == 256) ? xcd_run(bid, G) : bid; for (int it = bid; it < 256 + 1536; it += G) { if (it < 256) s5_item(lds, p, it); else dil_item(lds, p, it - 256 - bid + rb); } }
    SYNC(2);
    PHASE(3) { const int Gg = G >= 256 ? 128 : G / 2;
        Sched2D S{(const char*)(ws + OFF_YBUF), (const char*)(ws + OFF_WGLU), (size_t)256 * 1024 * 2, (size_t)256 * 1024 * 2, 32, 4, Gg, bid};
        EpiGlu E{(const bf16_t*)(ws + OFF_YBUF), (const bf16_t*)(ws + OFF_A), p.glu_b, (bf16_t*)(ws + OFF_MIX)}; gemm_phase(lds, 1024, 1024, 1024, S, E);
        if (bid >= Gg) merge_rows(p, bid - Gg, G - Gg); }
    SYNC(3);
    PHASE(4) { Sched2D S{(const char*)(ws + OFF_MIX), (const char*)(ws + OFF_WOUT0), (size_t)256 * 2048 * 2, (size_t)256 * 2048 * 2, 32, 16, G, bid};
        EpiResid E{p.x, p.out, (bf16_t*)(ws + OFF_B), (float*)(ws + OFF_SSQ)}; gemm_phase(lds, 2048, 2048, 2048, S, E); }
    SYNC(4);
    PHASE(5) { const float* ssq = (const float*)(ws + OFF_SSQ); float* rs1 = (float*)(ws + OFF_RS1);
        for (int row = bid * 512 + threadIdx.x; row < NTOK; row += G * 512) { float s = 0.f; for (int i = 0; i < 64; i += 4) { const f32x4 v = *(const f32x4*)(ssq + (size_t)row * 64 + i); s += (v.x + v.y) + (v.z + v.w); } rs1[row] = rsqrtf(s * (1.f / DM) + EPS); } }
    SYNC(5);
    PHASE(6) { { Sched2D S{(const char*)(ws + OFF_B), (const char*)(ws + OFF_WIN1), (size_t)256 * 4096 * 2, (size_t)256 * 4096 * 2, 32, 24, G, bid};
          EpiProj1 E{(bf16_t*)(ws + OFF_PROJ1), (const float*)(ws + OFF_RS1)}; gemm_phase(lds, 4096, 4096, 4096, S, E); }
        if (G >= 128) {
            if (bid < 64) { SchedGateSplit S{(const char*)(ws + OFF_B), (const char*)(ws + OFF_WIN1), bid}; EpiGatePart E{(float*)(ws + OFF_GP), (const float*)(ws + OFF_RS1)}; gemm_phase(lds, p.k2048, 4096, 4096, S, E); }
            else phase0b(lds, p, bid - 64, G - 64);
        } else { for (int c = bid; c < 64; c += G) { SchedGateSplit S{(const char*)(ws + OFF_B), (const char*)(ws + OFF_WIN1), c}; EpiGatePart E{(float*)(ws + OFF_GP), (const float*)(ws + OFF_RS1)}; gemm_phase(lds, p.k2048, 4096, 4096, S, E); }
            phase0b(lds, p, bid, G); } }
    SYNC(6);
    PHASE(7) phase7(lds, p);
    SYNC(7);
    PHASE(8) { Sched2D S{(const char*)(ws + OFF_PROJ1), (const char*)(ws + OFF_WQ), (size_t)256 * ODD_INP * 2, (size_t)256 * 1536 * 2, 32, 32, G, bid};
        EpiQ E{(bf16_t*)(ws + OFF_QBUF), (bf16_t*)(ws + OFF_B), (const float*)(ws + OFF_RSQ), rope, (bf16_t*)(ws + OFF_D)}; gemm_phase(lds, 1536, ODD_INP, 1536, S, E); }
    SYNC(8);
    PHASE(9) {
#ifndef NO9A
 { SchedQlat S{(const char*)(ws + OFF_QBUF), (const char*)(ws + OFF_WUK), G, bid}; EpiQlat E{(bf16_t*)(ws + OFF_D), (const bf16_t*)(ws + OFF_QBUF)}; gemm_phase(lds, p.k128, 4096, 128, S, E); }
#endif
#ifndef NO9B
        { SchedIdx S{(const char*)(ws + OFF_B), (const char*)(ws + OFF_KIDX), G, bid}; EpiIdx E{(float*)(ws + OFF_ISC), (const float*)(ws + OFF_WIDX), (f32x4){0.f, 0.f, 0.f, 0.f}, (f32x4){0.f, 0.f, 0.f, 0.f}, -1}; gemm_phase(lds, p.k128, 128, 128, S, E); }
#endif
 }
    SYNC(9);
    PHASE(10) { const int wid = threadIdx.x >> 6;
#ifndef NO_TOPK
        REP(10) { topk_phase(p); }
#endif
        __threadfence_block(); __syncthreads();
#ifndef NO_DSA
        REP(11) { dsa_phase(lds, p, _r == _nr - 1); __syncthreads(); }
#endif
 }
    SYNC(10);
    PHASE(11) { SchedOVd S{(const char*)(ws + OFF_D), (const char*)(ws + OFF_WUV), G, bid}; EpiOVd E{(bf16_t*)(ws + OFF_B), (const bf16_t*)(ws + OFF_PROJ1), (const float*)(ws + OFF_GP)}; gemm_phase(lds, p.k512, QLD, 512, S, E); }
    SYNC(11);
    PHASE(12) { Sched2D S{(const char*)(ws + OFF_B), (const char*)(ws + OFF_WOUT1), (size_t)256 * 4096 * 2, (size_t)256 * 4096 * 2, 32, 16, G, bid};
        EpiResid E{p.out, p.out, nullptr, (float*)(ws + OFF_SSQ)}; gemm_phase(lds, 4096, 4096, 4096, S, E); }
    SYNC(12);
    PHASE(13) { const float* ssq = (const float*)(ws + OFF_SSQ); const int lane = threadIdx.x & 63, wid = threadIdx.x >> 6;
        for (int row = bid * 8 + wid; row < NTOK; row += G * 8) { const float s = wave_sum(ssq[(size_t)row * 64 + lane]); const float rs = rsqrtf(s * (1.f / DM) + EPS); float* o = p.out + (size_t)row * DM;
#pragma unroll 4
            for (int i = 0; i < 16; ++i) { const int c = (i * 64 + lane) * 4; const f32x4 g = *(const f32x4*)(p.final_norm + c); *(f32x4*)(o + c) = *(const f32x4*)(o + c) * rs * g; } } }
}

#ifndef REPMASK
#define REPMASK 0
#endif
extern "C" void kernel_launch(void* const* d_in, const int* in_sizes, int n_in, void* d_out, int out_size, void* d_ws, size_t ws_size, hipStream_t stream) {
    static int grid_blocks = 0;
    if (!grid_blocks) {
        int dev = 0, cus = 0, per_cu = 0;
        hipGetDevice(&dev);
        hipDeviceGetAttribute(&cus, hipDeviceAttributeMultiprocessorCount, dev);
        hipFuncSetAttribute((const void*)fwd_megakernel, hipFuncAttributeMaxDynamicSharedMemorySize, LDS_BYTES);
        hipOccupancyMaxActiveBlocksPerMultiprocessor(&per_cu, fwd_megakernel, 512, LDS_BYTES);
        if (per_cu > 1) per_cu = 1;
        grid_blocks = cus * per_cu;
        if (ws_size < OFF_END) fprintf(stderr, "workspace too small: %zu < %zu\n", ws_size, (size_t)OFF_END);
    }
    Params p{};
    const float** f = (const float**)&p;
    for (int i = 0; i < 25; ++i) f[i] = (const float*)d_in[i];
    p.out = (float*)d_out; p.ws = (unsigned char*)d_ws; p.ph_lo = 0; p.ph_hi = 13; p.k128 = 128; p.rep = REPMASK; p.k2048 = 2048; p.k512 = 512;
    hipMemsetAsync((unsigned char*)d_ws + OFF_BAR, 0, XCD_BAR_WORDS * 4, stream);
    void* args[] = {&p};
    hipError_t e = hipLaunchCooperativeKernel((void*)fwd_megakernel, dim3(grid_blocks), dim3(512), args, LDS_BYTES, stream);
    if (e != hipSuccess) fprintf(stderr, "cooperative launch failed: %s (grid %d)\n", hipGetErrorString(e), grid_blocks);
}
```

```cpp
#include <hip/hip_runtime.h>
#include <hip/hip_cooperative_groups.h>
#include <cstdio>
namespace cg = cooperative_groups;

#define LAS __attribute__((address_space(3)))
typedef unsigned short bf16_t;
typedef short bf16x8 __attribute__((ext_vector_type(8)));
typedef short s16x4 __attribute__((ext_vector_type(4)));
typedef float f32x4 __attribute__((ext_vector_type(4)));
typedef unsigned u32x4 __attribute__((ext_vector_type(4)));
typedef unsigned u32x2 __attribute__((ext_vector_type(2)));

constexpr int DM = 4096, BATCH = 4, SEQ = 2048, NTOK = BATCH * SEQ;
constexpr int EVEN_IN = 12288, ODD_IN = 6336, ODD_INP = 6400;
constexpr int QLD = 17408;
constexpr int KVLD = 544;
constexpr float EPS = 1e-6f;
constexpr float LOG2E = 1.4426950408889634f;
constexpr float ATT_SCALE = 0.08838834764831845f * LOG2E;

constexpr size_t SZ_WIN1 = (size_t)ODD_INP * 4096 * 2, SZ_WQ = (size_t)8192 * 1536 * 2, SZ_WUK = (size_t)32 * 512 * 128 * 2,
                 SZ_WUV = (size_t)16 * 256 * 1024 * 2, SZ_WOUT1 = (size_t)4096 * 4096 * 2;
constexpr size_t OFF_WIN1 = 0, OFF_WQ = OFF_WIN1 + SZ_WIN1, OFF_WUK = OFF_WQ + SZ_WQ, OFF_WUV = OFF_WUK + SZ_WUK, OFF_WOUT1 = OFF_WUV + SZ_WUV;
constexpr size_t OFF_ROPE = OFF_WOUT1 + SZ_WOUT1;
constexpr size_t OFF_SSQ = OFF_ROPE + 2048 * 16 * 8;
constexpr size_t OFF_RS1 = OFF_SSQ + (size_t)NTOK * 64 * 4;
constexpr size_t OFF_LSE = OFF_RS1 + NTOK * 4;
constexpr size_t OFF_B = OFF_LSE + (size_t)3 * NTOK * 8 * 4;
constexpr size_t OFF_A = OFF_B + (size_t)NTOK * 4096 * 2;
constexpr size_t OFF_PROJ1 = OFF_A, OFF_QBUF = OFF_PROJ1 + (size_t)NTOK * ODD_INP * 2, OFF_CKV = OFF_QBUF + (size_t)NTOK * 4096 * 2,
                 OFF_KIDX = OFF_CKV + (size_t)NTOK * KVLD * 2, OFF_WIDX = OFF_KIDX + (size_t)NTOK * 128 * 2, OFF_RSQ = OFF_WIDX + (size_t)NTOK * 32 * 4,
                 OFF_SEL = OFF_RSQ + NTOK * 4, OFF_A_END = OFF_SEL + (size_t)NTOK * 256 * 2;
constexpr size_t OFF_C = OFF_A + (size_t)NTOK * EVEN_IN * 2;
static_assert(OFF_A_END <= OFF_C, "region A overflow");
constexpr size_t OFF_YBUF = OFF_C, OFF_OBUF = OFF_YBUF + (size_t)NTOK * 1024 * 2, OFF_MIX = OFF_OBUF + (size_t)3 * NTOK * 1024 * 2, OFF_C_END = OFF_MIX + (size_t)NTOK * 2048 * 2;
constexpr size_t OFF_ISC = OFF_C;
static_assert((size_t)NTOK * 2048 * 4 <= OFF_C_END - OFF_C, "iscore");
constexpr size_t OFF_D = OFF_C_END;
constexpr size_t OFF_WIN0 = OFF_D, OFF_WGLU = OFF_WIN0 + (size_t)EVEN_IN * 4096 * 2, OFF_WOUT0 = OFF_WGLU + (size_t)1024 * 1024 * 2;
constexpr size_t OFF_BAR = OFF_D + (size_t)NTOK * QLD * 2;
constexpr size_t OFF_GP = OFF_BAR + 16384;
constexpr size_t OFF_END = OFF_GP + (size_t)2 * NTOK * 256 * 4;

constexpr int LDS_BYTES = 153600;

struct Params {
    const float *x, *even_norm, *even_w_in, *lam_re, *lam_im, *log_step, *b_re, *b_im, *c_re, *c_im, *s5_d, *glu_w, *glu_b, *even_w_out,
        *odd_norm, *odd_w_in, *q_norm, *kv_norm, *idx_k_norm, *w_uq, *w_uk, *w_uv, *w_iq, *odd_w_out, *final_norm;
    float* out; unsigned char* ws; int ph_lo, ph_hi, k128, rep, k2048, k512;
};

__device__ __forceinline__ unsigned cvt_pk_bf16(float lo, float hi) { unsigned r; asm volatile("v_cvt_pk_bf16_f32 %0, %1, %2" : "=v"(r) : "v"(lo), "v"(hi)); return r; }
__device__ __forceinline__ float bf2f(unsigned short b) { return __uint_as_float(((unsigned)b) << 16); }
__device__ __forceinline__ float bflo(unsigned u) { return __uint_as_float(u << 16); }
__device__ __forceinline__ float bfhi(unsigned u) { return __uint_as_float(u & 0xffff0000u); }
__device__ __forceinline__ u32x2 pack4(f32x4 v) { u32x2 r; r.x = cvt_pk_bf16(v.x, v.y); r.y = cvt_pk_bf16(v.z, v.w); return r; }
__device__ __forceinline__ f32x4 unpack4(u32x2 u) { f32x4 r; r.x = bflo(u.x); r.y = bfhi(u.x); r.z = bflo(u.y); r.w = bfhi(u.y); return r; }
__device__ __forceinline__ float silu_f(float z) { return z / (1.f + __expf(-z)); }
__device__ __forceinline__ float sigmoid_f(float z) { return 1.f / (1.f + __expf(-z)); }
typedef unsigned u32x2p_t __attribute__((ext_vector_type(2)));
__device__ __forceinline__ float xor32_val(float v, int lane) { const u32x2p_t r = __builtin_amdgcn_permlane32_swap(__float_as_uint(v), __float_as_uint(v), false, false); return __uint_as_float(lane < 32 ? r.y : r.x); }
__device__ __forceinline__ float sum_xor32(float v) { const u32x2p_t r = __builtin_amdgcn_permlane32_swap(__float_as_uint(v), __float_as_uint(v), false, false); return __uint_as_float(r.x) + __uint_as_float(r.y); }
__device__ __forceinline__ float sum_xor16(float v) { const u32x2p_t r = __builtin_amdgcn_permlane16_swap(__float_as_uint(v), __float_as_uint(v), false, false); return __uint_as_float(r.x) + __uint_as_float(r.y); }
__device__ __forceinline__ float max_xor32(float v) { const u32x2p_t r = __builtin_amdgcn_permlane32_swap(__float_as_uint(v), __float_as_uint(v), false, false); return fmaxf(__uint_as_float(r.x), __uint_as_float(r.y)); }
__device__ __forceinline__ float max_xor16(float v) { const u32x2p_t r = __builtin_amdgcn_permlane16_swap(__float_as_uint(v), __float_as_uint(v), false, false); return fmaxf(__uint_as_float(r.x), __uint_as_float(r.y)); }
__device__ __forceinline__ float wave_sum(float v) {
    v += __int_as_float(__builtin_amdgcn_update_dpp(0, __float_as_int(v), 0xB1, 0xf, 0xf, false));
    v += __int_as_float(__builtin_amdgcn_update_dpp(0, __float_as_int(v), 0x4E, 0xf, 0xf, false));
    v += __int_as_float(__builtin_amdgcn_update_dpp(0, __float_as_int(v), 0x141, 0xf, 0xf, false));
    v += __int_as_float(__builtin_amdgcn_update_dpp(0, __float_as_int(v), 0x140, 0xf, 0xf, false));
    return sum_xor32(sum_xor16(v));
}
__device__ __forceinline__ float row16_sum(float v) {
    v += __int_as_float(__builtin_amdgcn_update_dpp(0, __float_as_int(v), 0xB1, 0xf, 0xf, false));
    v += __int_as_float(__builtin_amdgcn_update_dpp(0, __float_as_int(v), 0x4E, 0xf, 0xf, false));
    v += __int_as_float(__builtin_amdgcn_update_dpp(0, __float_as_int(v), 0x141, 0xf, 0xf, false));
    v += __int_as_float(__builtin_amdgcn_update_dpp(0, __float_as_int(v), 0x140, 0xf, 0xf, false));
    return v;
}

constexpr int BM = 256, BK = 64, HALF = 128, HTB = HALF * BK * 2, NXCD = 8, WGM = 8;
__device__ __forceinline__ int lds_byte(int r, int c) { const int st = (r >> 4) * 2 + (c >> 5), rr = r & 15, cc = c & 31, ob = rr * 64 + cc * 2; return st * 1024 + (ob ^ (((ob >> 9) & 1) << 5)); }
__device__ __forceinline__ int perm32(int rho) { const int n = rho >> 4, i = rho & 15; return 8 * (i >> 2) + 4 * n + (i & 3); }
__device__ __forceinline__ void stage_rc(int b, int& R, int& C) { const int st = b / 1024, sb = b % 1024, swz = sb ^ (((sb >> 9) & 1) << 5); R = (st >> 1) * 16 + swz / 64; C = (st & 1) * 32 + (swz % 64) / 2; }

struct Unit { const char* a; const char* b; int pm, pn, z; };
template <class E, class = void> struct EpiAmap { static constexpr bool v = false; };
template <class E> struct EpiAmap<E, decltype((void)E::AMAP)> { static constexpr bool v = E::AMAP; };
template <class E, class = void> struct EpiPref { static constexpr bool v = false; };
template <class E> struct EpiPref<E, decltype((void)E::PREF)> { static constexpr bool v = E::PREF; };
template <class E, class = void> struct EpiDiag { static constexpr bool v = false; };
template <class E> struct EpiDiag<E, decltype((void)E::DIAG)> { static constexpr bool v = E::DIAG; };

__device__ __forceinline__ void swz_tile(int L, int nM, int nN, int& pm, int& pn) {
    const int nwg = nM * nN; int wgid = L;
    { const int q = nwg / NXCD, r = nwg % NXCD, xcd = wgid % NXCD, off = wgid / NXCD; wgid = (xcd < r ? xcd * (q + 1) : r * (q + 1) + (xcd - r) * q) + off; }
    const int nig = WGM * nN, gid = wgid / nig, fm = gid * WGM, gsz = (nM - fm) < WGM ? (nM - fm) : WGM;
    pm = fm + ((wgid % nig) % gsz); pn = (wgid % nig) / gsz;
}
__device__ __forceinline__ int xcd_run(int c, int G) { return (G & 7) ? c : (c & 7) * (G >> 3) + (c >> 3); }
struct Sched2D {
    const char* A; const char* B; size_t at, bt; int nM, nN, G, c;
    __device__ __forceinline__ bool next(int i, Unit& u) const {
        const long L = (long)i * G + c; if (c >= G || L >= (long)nM * nN) return false;
        swz_tile((int)L, nM, nN, u.pm, u.pn); u.z = 0; u.a = A + (size_t)u.pm * at; u.b = B + (size_t)u.pn * bt; return true; }
};

template <class Epi, class Sched>
__device__ __forceinline__ void gemm_phase(LAS unsigned char* lds, const int K, const int lda, const int ldb, const Sched& S, const Epi& E) {
    const int tid = threadIdx.x, wid = __builtin_amdgcn_readfirstlane(tid >> 6), lane = tid & 63, wr = wid >> 2, wc = wid & 3, fr = lane & 15, fq = lane >> 4;
    const int nt = K / BK;
    unsigned voffA[2], voffB[2];
#pragma unroll
    for (int i = 0; i < 2; ++i) { int R, C; stage_rc(tid * 16 + i * 8192, R, C); const int Rb = Epi::PERM ? ((R & ~31) + perm32(R & 31)) : R; const int Ra = EpiAmap<Epi>::v ? (((R >> 6) * 4 + ((R & 15) >> 2)) * 32 + (R & 3) * 8 + ((R >> 4) & 3)) : R; voffA[i] = (unsigned)(Ra * lda + C) * 2u; voffB[i] = (unsigned)(Rb * ldb + C) * 2u; }
    const size_t kstep = (size_t)(BK * 2);
    const size_t hstepA = EpiDiag<Epi>::v ? (size_t)512 * 2 : (EpiAmap<Epi>::v ? (size_t)4 * lda * 2 : (size_t)HALF * lda * 2), hstepB = (size_t)HALF * ldb * 2;
    const unsigned ldsw = (unsigned)wid * 1024u;
    const int aoff = lds_byte(wr * 64 + fr, fq * 8), boff = lds_byte(wc * 32 + fr, fq * 8);
#define PG8_SA(b, h) (((b) * 2 + (h)) * HTB)
#define PG8_SB(b, h) ((4 + (b) * 2 + (h)) * HTB)
#define PG8_STAGE(bufoff, gbase, voff) do { _Pragma("unroll") for (int _i = 0; _i < 2; ++_i) \
        __builtin_amdgcn_global_load_lds((const unsigned*)((const char*)(gbase) + (voff)[_i]), (LAS unsigned*)(lds + (bufoff) + ldsw + _i * 8192), 16, 0, 0); } while (0)
#define PG8_LDA(dst, b, h) do { _Pragma("unroll") for (int m = 0; m < 4; ++m) _Pragma("unroll") for (int k = 0; k < 2; ++k) dst[m][k] = *(const LAS bf16x8*)(lds + PG8_SA(b, h) + aoff + m * 2048 + k * 1024); } while (0)
#define PG8_LDB(dst, b, h) do { _Pragma("unroll") for (int n = 0; n < 2; ++n) _Pragma("unroll") for (int k = 0; k < 2; ++k) dst[n][k] = *(const LAS bf16x8*)(lds + PG8_SB(b, h) + boff + n * 2048 + k * 1024); } while (0)
#define PG8_MMA(ai, bj, At, Bt) do { __builtin_amdgcn_s_setprio(1); _Pragma("unroll") for (int m = 0; m < 4; ++m) _Pragma("unroll") for (int n = 0; n < 2; ++n) _Pragma("unroll") for (int k = 0; k < 2; ++k) \
        acc[ai][bj][m][n] = __builtin_amdgcn_mfma_f32_16x16x32_bf16(Bt[n][k], At[m][k], acc[ai][bj][m][n], 0, 0, 0); __builtin_amdgcn_s_setprio(0); } while (0)
#define PG8_MMA_OFF(ai, bj, At, Bt) do { if constexpr (!EpiDiag<Epi>::v) PG8_MMA(ai, bj, At, Bt); } while (0)
#define PG8_WAIT_V(n) asm volatile("s_waitcnt vmcnt(" #n ")" ::: "memory")
#define PG8_WAIT_L(n) asm volatile("s_waitcnt lgkmcnt(" #n ")" ::: "memory")
#define PG8_BAR __builtin_amdgcn_s_barrier()
#define PG8_SCHED __builtin_amdgcn_sched_barrier(0)
    Unit cur, nxt; int ui = 0;
    if (!S.next(0, cur)) return;
    f32x4 acc[2][2][4][2];
#pragma unroll
    for (int a = 0; a < 2; ++a)
#pragma unroll
        for (int b = 0; b < 2; ++b)
#pragma unroll
            for (int m = 0; m < 4; ++m)
#pragma unroll
                for (int n = 0; n < 2; ++n) acc[a][b][m][n] = (f32x4){0.f, 0.f, 0.f, 0.f};
    bf16x8 At[4][2], B0[2][2], B1[2][2];
    const char* cA = cur.a; const char* cB = cur.b;
    PG8_STAGE(PG8_SB(0, 0), cB, voffB); PG8_STAGE(PG8_SA(0, 0), cA, voffA); PG8_STAGE(PG8_SB(0, 1), cB + hstepB, voffB); PG8_STAGE(PG8_SA(0, 1), cA + hstepA, voffA);
    if (wr == 1) PG8_BAR;
    PG8_WAIT_V(4); PG8_BAR;
    PG8_STAGE(PG8_SB(1, 0), cB + kstep, voffB); PG8_STAGE(PG8_SA(1, 0), cA + kstep, voffA); PG8_STAGE(PG8_SB(1, 1), cB + hstepB + kstep, voffB);
    PG8_WAIT_V(6); PG8_BAR;
    for (;;) {
        const bool has_next = S.next(ui + 1, nxt);
        const char* nA = has_next ? nxt.a : cA; const char* nB = has_next ? nxt.b : cB;
        for (int t = 0; t < nt; t += 2) {
            const bool last = (t == nt - 2);
            const char* a1 = cA + (size_t)(t + 1) * kstep;
            const char* a2 = last ? nA : cA + (size_t)(t + 2) * kstep; const char* b2 = last ? nB : cB + (size_t)(t + 2) * kstep;
            const char* a3 = a2 + kstep; const char* b3 = b2 + kstep;
            PG8_LDB(B0, 0, 0); PG8_SCHED; PG8_LDA(At, 0, 0); PG8_STAGE(PG8_SA(1, 1), a1 + hstepA, voffA);
            PG8_WAIT_L(8); PG8_BAR; PG8_WAIT_L(0); PG8_MMA(0, 0, At, B0); PG8_BAR; PG8_SCHED;
            PG8_LDB(B1, 0, 1); PG8_STAGE(PG8_SB(0, 0), b2, voffB);
            PG8_BAR; PG8_WAIT_L(0); PG8_MMA_OFF(0, 1, At, B1); PG8_BAR;
            PG8_LDA(At, 0, 1); PG8_STAGE(PG8_SA(0, 0), a2, voffA);
            PG8_BAR; PG8_WAIT_L(0); PG8_MMA_OFF(1, 0, At, B0); PG8_BAR; PG8_SCHED;
            PG8_STAGE(PG8_SB(0, 1), b2 + hstepB, voffB);
            PG8_WAIT_V(6); PG8_BAR; PG8_MMA(1, 1, At, B1); PG8_BAR;
            PG8_LDB(B0, 1, 0); PG8_SCHED; PG8_LDA(At, 1, 0); PG8_STAGE(PG8_SA(0, 1), a2 + hstepA, voffA);
            PG8_WAIT_L(8); PG8_BAR; PG8_WAIT_L(0); PG8_MMA(0, 0, At, B0); PG8_BAR; PG8_SCHED;
            PG8_LDB(B1, 1, 1); PG8_STAGE(PG8_SB(1, 0), b3, voffB);
            PG8_BAR; PG8_WAIT_L(0); PG8_MMA_OFF(0, 1, At, B1); PG8_BAR;
            PG8_LDA(At, 1, 1); PG8_STAGE(PG8_SA(1, 0), a3, voffA);
            PG8_BAR; PG8_WAIT_L(0); PG8_MMA_OFF(1, 0, At, B0); PG8_BAR; PG8_SCHED;
            PG8_STAGE(PG8_SB(1, 1), b3 + hstepB, voffB);
            PG8_WAIT_V(6); PG8_BAR; PG8_MMA(1, 1, At, B1); PG8_BAR;
        }
        E(acc, cur, wr, wc, fr, fq);
        if (!has_next) break;
        if constexpr (EpiPref<Epi>::v) E.prefetch(nxt, wr, fr);
#pragma unroll
        for (int a = 0; a < 2; ++a)
#pragma unroll
            for (int b = 0; b < 2; ++b)
#pragma unroll
                for (int m = 0; m < 4; ++m)
#pragma unroll
                    for (int n = 0; n < 2; ++n) acc[a][b][m][n] = (f32x4){0.f, 0.f, 0.f, 0.f};
        cur = nxt; cA = nA; cB = nB; ++ui;
    }
    PG8_WAIT_V(0);
    if (wr == 0) PG8_BAR;
    PG8_BAR;
#undef PG8_SA
#undef PG8_SB
#undef PG8_STAGE
#undef PG8_LDA
#undef PG8_LDB
#undef PG8_MMA
#undef PG8_MMA_OFF
#undef PG8_WAIT_V
#undef PG8_WAIT_L
#undef PG8_BAR
#undef PG8_SCHED
}

typedef const f32x4 (&AccRef)[2][2][4][2];
#define EPI_ROWLOOP for (int ai = 0; ai < 2; ++ai) for (int m = 0; m < 4; ++m)
#define EPI_ROW(u) ((u).pm * BM + ai * HALF + wr * 64 + m * 16 + fr)
#define EPI_COL(u) ((u).pn * BM + bj * HALF + wc * 32 + n * 16 + 4 * fq)

#define EPI_COL8(u) ((u).pn * BM + bj * HALF + wc * 32 + 8 * fq)
__device__ __forceinline__ u32x4 pack8(f32x4 a, f32x4 b) { u32x4 r; r.x = cvt_pk_bf16(a.x, a.y); r.y = cvt_pk_bf16(a.z, a.w); r.z = cvt_pk_bf16(b.x, b.y); r.w = cvt_pk_bf16(b.z, b.w); return r; }
__device__ __forceinline__ void unpack8(u32x4 u, f32x4& a, f32x4& b) { a.x = bflo(u.x); a.y = bfhi(u.x); a.z = bflo(u.y); a.w = bfhi(u.y); b.x = bflo(u.z); b.y = bfhi(u.z); b.z = bflo(u.w); b.w = bfhi(u.w); }
struct RopeCS { float2 c[8]; };
__device__ __forceinline__ RopeCS rope_load(const float2* tab, int pos, int fq) { RopeCS r; const float2* t = tab + pos * 16 + 8 * (fq & 1);
#pragma unroll
    for (int e = 0; e < 8; ++e) r.c[e] = t[e];
    return r; }
__device__ __forceinline__ void rope_apply(f32x4& v0, f32x4& v1, const RopeCS& r, int fq) {
    const bool lo = fq < 2;
#pragma unroll
    for (int e = 0; e < 4; ++e) { const float o0 = xor32_val(v0[e], lo ? 0 : 32), o1 = xor32_val(v1[e], lo ? 0 : 32); const float2 c0 = r.c[e], c1 = r.c[4 + e];
        v0[e] = lo ? (v0[e] * c0.x - o0 * c0.y) : (v0[e] * c0.x + o0 * c0.y); v1[e] = lo ? (v1[e] * c1.x - o1 * c1.y) : (v1[e] * c1.x + o1 * c1.y); }
}
#define EPI_ROW_(u, ai, m) ((u).pm * BM + (ai) * HALF + wr * 64 + (m) * 16 + fr)

struct EpiProj0 {
    static constexpr bool PERM = true;
    bf16_t* out; const float2* rope;
    __device__ __forceinline__ void operator()(AccRef acc, const Unit& u, int wr, int wc, int fr, int fq) const {
        const int rel = u.pn * BM - 2048; const bool qk = rel >= 0 && rel < 9216 && (rel % 3072) < 2048; const bool isq = qk && (rel % 3072) < 1024;
        const float sc = isq ? ATT_SCALE : 1.f; const bool dorope = qk && wc == 0;
#pragma unroll
        for (int ai = 0; ai < 2; ++ai)
#pragma unroll
            for (int mh = 0; mh < 2; ++mh) { RopeCS cs[2];
                if (dorope) { cs[0] = rope_load(rope, EPI_ROW_(u, ai, 2 * mh) & 2047, fq); cs[1] = rope_load(rope, EPI_ROW_(u, ai, 2 * mh + 1) & 2047, fq); }
#pragma unroll
                for (int mm = 0; mm < 2; ++mm) { const int m = 2 * mh + mm, row = EPI_ROW_(u, ai, m);
#pragma unroll
                    for (int bj = 0; bj < 2; ++bj) { f32x4 v0 = acc[ai][bj][m][0], v1 = acc[ai][bj][m][1];
                        if (dorope) rope_apply(v0, v1, cs[mm], fq);
                        *(u32x4*)(out + (size_t)row * EVEN_IN + EPI_COL8(u)) = pack8(v0 * sc, v1 * sc); } } }
    }
};
struct EpiGlu {
    static constexpr bool PERM = true;
    const bf16_t* y; const bf16_t* proj0; const float* bias; bf16_t* mix;
    __device__ __forceinline__ void operator()(AccRef acc, const Unit& u, int wr, int wc, int fr, int fq) const {
        f32x4 bv[2][2];
#pragma unroll
        for (int bj = 0; bj < 2; ++bj) { const int col = EPI_COL8(u); bv[bj][0] = *(const f32x4*)(bias + col); bv[bj][1] = *(const f32x4*)(bias + col + 4); }
#pragma unroll
        for (int ai = 0; ai < 2; ++ai)
#pragma unroll
            for (int mh = 0; mh < 2; ++mh) { u32x4 yv[2][2], zv[2][2];
#pragma unroll
                for (int mm = 0; mm < 2; ++mm)
#pragma unroll
                    for (int bj = 0; bj < 2; ++bj) { const int row = EPI_ROW_(u, ai, 2 * mh + mm), col = EPI_COL8(u);
                        yv[mm][bj] = *(const u32x4*)(y + (size_t)row * 1024 + col); zv[mm][bj] = *(const u32x4*)(proj0 + (size_t)row * EVEN_IN + 1024 + col); }
#pragma unroll
                for (int mm = 0; mm < 2; ++mm)
#pragma unroll
                    for (int bj = 0; bj < 2; ++bj) { const int m = 2 * mh + mm, row = EPI_ROW_(u, ai, m), col = EPI_COL8(u); f32x4 y0, y1, z0, z1, r0, r1;
                        unpack8(yv[mm][bj], y0, y1); unpack8(zv[mm][bj], z0, z1);
#pragma unroll
                        for (int e = 0; e < 4; ++e) { r0[e] = y0[e] * sigmoid_f(acc[ai][bj][m][0][e] + bv[bj][0][e]) * silu_f(z0[e]); r1[e] = y1[e] * sigmoid_f(acc[ai][bj][m][1][e] + bv[bj][1][e]) * silu_f(z1[e]); }
                        *(u32x4*)(mix + (size_t)row * 2048 + col) = pack8(r0, r1); } }
    }
};
struct EpiResid {
    static constexpr bool PERM = true;
    const float* xin; float* xo; bf16_t* xb; float* ssq;
    __device__ __forceinline__ void operator()(AccRef acc, const Unit& u, int wr, int wc, int fr, int fq) const {
#pragma unroll
        for (int ai = 0; ai < 2; ++ai)
#pragma unroll
            for (int mh = 0; mh < 2; ++mh) { f32x4 xv[2][2][2];
#pragma unroll
                for (int mm = 0; mm < 2; ++mm)
#pragma unroll
                    for (int bj = 0; bj < 2; ++bj) { const size_t o = (size_t)EPI_ROW_(u, ai, 2 * mh + mm) * DM + EPI_COL8(u); xv[mm][bj][0] = *(const f32x4*)(xin + o); xv[mm][bj][1] = *(const f32x4*)(xin + o + 4); }
#pragma unroll
                for (int mm = 0; mm < 2; ++mm) { const int m = 2 * mh + mm, row = EPI_ROW_(u, ai, m); float ss = 0.f;
#pragma unroll
                    for (int bj = 0; bj < 2; ++bj) { const size_t o = (size_t)row * DM + EPI_COL8(u);
                        const f32x4 v0 = xv[mm][bj][0] + acc[ai][bj][m][0], v1 = xv[mm][bj][1] + acc[ai][bj][m][1];
                        *(f32x4*)(xo + o) = v0; *(f32x4*)(xo + o + 4) = v1;
                        if (xb) *(u32x4*)(xb + o) = pack8(v0, v1);
                        ss += v0.x * v0.x + v0.y * v0.y + v0.z * v0.z + v0.w * v0.w + v1.x * v1.x + v1.y * v1.y + v1.z * v1.z + v1.w * v1.w; }
                    ss = sum_xor16(ss); ss = sum_xor32(ss);
                    if (fq == 0) ssq[(size_t)row * 64 + u.pn * 4 + wc] = ss; } }
    }
};
struct EpiProj1 {
    static constexpr bool PERM = true;
    bf16_t* out; const float* rs;
    __device__ __forceinline__ void operator()(AccRef acc, const Unit& u, int wr, int wc, int fr, int fq) const {
        float rsv[2][4];
#pragma unroll
        EPI_ROWLOOP rsv[ai][m] = rs[EPI_ROW(u)];
#pragma unroll
        EPI_ROWLOOP { const int row = EPI_ROW(u); const float s = rsv[ai][m];
#pragma unroll
            for (int bj = 0; bj < 2; ++bj) *(u32x4*)(out + (size_t)row * ODD_INP + EPI_COL8(u)) = pack8(acc[ai][bj][m][0] * s, acc[ai][bj][m][1] * s); }
    }
};
struct EpiQ {
    static constexpr bool PERM = true;
    bf16_t* qbuf; bf16_t* qidx; const float* rs; const float2* rope; bf16_t* qlat;
    __device__ __forceinline__ void operator()(AccRef acc, const Unit& u, int wr, int wc, int fr, int fq) const {
        bf16_t* base = u.pn < 16 ? qbuf : qidx; const int colt = (u.pn & 15) * BM;
        float rsv[2][4];
#pragma unroll
        EPI_ROWLOOP rsv[ai][m] = rs[EPI_ROW(u)];
#pragma unroll
        for (int ai = 0; ai < 2; ++ai)
#pragma unroll
            for (int mh = 0; mh < 2; ++mh) { RopeCS cs[2];
                if (wc == 0) { cs[0] = rope_load(rope, EPI_ROW_(u, ai, 2 * mh) & 2047, fq); cs[1] = rope_load(rope, EPI_ROW_(u, ai, 2 * mh + 1) & 2047, fq); }
#pragma unroll
                for (int mm = 0; mm < 2; ++mm) { const int m = 2 * mh + mm, row = EPI_ROW_(u, ai, m); const float s = rsv[ai][m];
#pragma unroll
                    for (int bj = 0; bj < 2; ++bj) { f32x4 v0 = acc[ai][bj][m][0] * s, v1 = acc[ai][bj][m][1] * s;
                        if (wc == 0) { rope_apply(v0, v1, cs[mm], fq);
                            if (u.pn < 16) *(u32x4*)(qlat + (size_t)row * QLD + (u.pn * 2 + bj) * 544 + 512 + 8 * fq) = pack8(v0 * ATT_SCALE, v1 * ATT_SCALE); }
                        *(u32x4*)(base + (size_t)row * 4096 + colt + bj * HALF + wc * 32 + 8 * fq) = pack8(v0, v1); } } }
    }
};
struct EpiQlat {
    static constexpr bool PERM = true;
    bf16_t* qlat; const bf16_t* qbuf;
    __device__ __forceinline__ void operator()(AccRef acc, const Unit& u, int wr, int wc, int fr, int fq) const {
#pragma unroll
        EPI_ROWLOOP { const int row = EPI_ROW(u); bf16_t* o = qlat + (size_t)row * QLD + u.z * 544;
#pragma unroll
            for (int bj = 0; bj < 2; ++bj) *(u32x4*)(o + EPI_COL8(u)) = pack8(acc[ai][bj][m][0], acc[ai][bj][m][1]); }
    }
};
struct EpiIdx {       static constexpr bool PERM = false, AMAP = true, PREF = true;
    float* isc; const float* widx; mutable f32x4 pwa, pwb; mutable int ptok;
    __device__ __forceinline__ void prefetch(const Unit& n, int wr, int fr) const { const int t = n.pm * 8 + wr * 4 + (fr >> 2); ptok = t; pwa = *(const f32x4*)(widx + t * 32 + (fr & 3) * 8); pwb = *(const f32x4*)(widx + t * 32 + (fr & 3) * 8 + 4); }
    __device__ __forceinline__ void operator()(AccRef acc, const Unit& u, int wr, int wc, int fr, int fq) const {
        const int token = u.pm * 8 + wr * 4 + (fr >> 2);
        f32x4 wa = pwa, wb = pwb;
        if (ptok != token) { wa = *(const f32x4*)(widx + token * 32 + (fr & 3) * 8); wb = *(const f32x4*)(widx + token * 32 + (fr & 3) * 8 + 4); }
        float* orow = isc + (size_t)token * 2048 + u.pn * BM + wc * 32 + 4 * fq;
#pragma unroll
        for (int bj = 0; bj < 2; ++bj)
#pragma unroll
            for (int n = 0; n < 2; ++n) { f32x4 r;
#pragma unroll
                for (int e = 0; e < 4; ++e) { float v = 0.f;
#pragma unroll
                    for (int m = 0; m < 4; ++m) { v += wa[m] * fmaxf(acc[0][bj][m][n][e], 0.f); v += wb[m] * fmaxf(acc[1][bj][m][n][e], 0.f); }
                    v += __int_as_float(__builtin_amdgcn_update_dpp(0, __float_as_int(v), 0xB1, 0xf, 0xf, false));
                    v += __int_as_float(__builtin_amdgcn_update_dpp(0, __float_as_int(v), 0x4E, 0xf, 0xf, false));
                    r[e] = v; }
                if ((fr & 3) == 0) *(f32x4*)(orow + bj * HALF + n * 16) = r; }
    }
};
struct EpiOV {
    static constexpr bool PERM = true;
    bf16_t* og; const bf16_t* proj1; const float* gp;
    __device__ __forceinline__ void operator()(AccRef acc, const Unit& u, int wr, int wc, int fr, int fq) const {
        if (u.pn != 15) {
#pragma unroll
            for (int ai = 0; ai < 2; ++ai) { u32x4 gv[4][2];
#pragma unroll
                for (int m = 0; m < 4; ++m)
#pragma unroll
                    for (int bj = 0; bj < 2; ++bj) gv[m][bj] = *(const u32x4*)(proj1 + (size_t)EPI_ROW_(u, ai, m) * ODD_INP + 2240 + EPI_COL8(u));
#pragma unroll
                for (int m = 0; m < 4; ++m)
#pragma unroll
                    for (int bj = 0; bj < 2; ++bj) { f32x4 g0, g1, r0, r1; unpack8(gv[m][bj], g0, g1);
#pragma unroll
                        for (int e = 0; e < 4; ++e) { r0[e] = acc[ai][bj][m][0][e] * silu_f(g0[e]); r1[e] = acc[ai][bj][m][1][e] * silu_f(g1[e]); }
                        *(u32x4*)(og + (size_t)EPI_ROW_(u, ai, m) * 4096 + EPI_COL8(u)) = pack8(r0, r1); } }
        } else {
#pragma unroll
        EPI_ROWLOOP { const int row = EPI_ROW(u);
#pragma unroll
            for (int bj = 0; bj < 2; ++bj) { const int col = EPI_COL8(u); f32x4 g0, g1;
                if (col >= 3904) { const float* g = gp + (size_t)row * 256 + (col - 3904); g0 = *(const f32x4*)g + *(const f32x4*)(g + (size_t)NTOK * 256); g1 = *(const f32x4*)(g + 4) + *(const f32x4*)(g + (size_t)NTOK * 256 + 4); }
                else unpack8(*(const u32x4*)(proj1 + (size_t)row * ODD_INP + 2240 + col), g0, g1);
                f32x4 r0, r1;
#pragma unroll
                for (int e = 0; e < 4; ++e) { r0[e] = acc[ai][bj][m][0][e] * silu_f(g0[e]); r1[e] = acc[ai][bj][m][1][e] * silu_f(g1[e]); }
                *(u32x4*)(og + (size_t)row * 4096 + col) = pack8(r0, r1); } }
        }
    }
};

struct EpiOVd {
    static constexpr bool PERM = true, DIAG = true;
    bf16_t* og; const bf16_t* proj1; const float* gp;
    __device__ __forceinline__ void operator()(AccRef acc, const Unit& u, int wr, int wc, int fr, int fq) const {
#pragma unroll
        for (int ai = 0; ai < 2; ++ai) { const int col = u.pn * 256 + ai * 128 + wc * 32 + 8 * fq; f32x4 g0[4], g1[4];
#pragma unroll
            for (int m = 0; m < 4; ++m) { const int row = u.pm * 128 + wr * 64 + m * 16 + fr;
                if (col >= 3904) { const float* g = gp + (size_t)row * 256 + (col - 3904); g0[m] = *(const f32x4*)g + *(const f32x4*)(g + (size_t)NTOK * 256); g1[m] = *(const f32x4*)(g + 4) + *(const f32x4*)(g + (size_t)NTOK * 256 + 4); }
                else unpack8(*(const u32x4*)(proj1 + (size_t)row * ODD_INP + 2240 + col), g0[m], g1[m]); }
#pragma unroll
            for (int m = 0; m < 4; ++m) { const int row = u.pm * 128 + wr * 64 + m * 16 + fr; f32x4 r0, r1;
#pragma unroll
                for (int e = 0; e < 4; ++e) { r0[e] = acc[ai][ai][m][0][e] * silu_f(g0[m][e]); r1[e] = acc[ai][ai][m][1][e] * silu_f(g1[m][e]); }
                *(u32x4*)(og + (size_t)row * 4096 + col) = pack8(r0, r1); } }
    }
};
struct SchedOVd {
    const char* olat; const char* wuv; int G, c;
    __device__ __forceinline__ bool next(int i, Unit& u) const {
        const int L = i * G + xcd_run(c, G); if (L >= 1024) return false;
        u.pn = L >> 6; u.pm = L & 63; u.z = 0;
        u.a = olat + ((size_t)u.pm * 128 * QLD + u.pn * 1024) * 2; u.b = wuv + (size_t)u.pn * 256 * 512 * 2; return true; }
};
struct EpiGatePart {
    static constexpr bool PERM = true;
    float* gp; const float* rs;
    __device__ __forceinline__ void operator()(AccRef acc, const Unit& u, int wr, int wc, int fr, int fq) const {
        float rsv[2][4];
#pragma unroll
        EPI_ROWLOOP rsv[ai][m] = rs[EPI_ROW(u)];
#pragma unroll
        EPI_ROWLOOP { const int row = EPI_ROW(u); const float s = rsv[ai][m]; float* o = gp + ((size_t)u.z * NTOK + row) * 256 + wc * 32 + 8 * fq;
#pragma unroll
            for (int bj = 0; bj < 2; ++bj) { *(f32x4*)(o + bj * HALF) = acc[ai][bj][m][0] * s; *(f32x4*)(o + bj * HALF + 4) = acc[ai][bj][m][1] * s; } }
    }
};
struct SchedGateSplit {
    const char* A; const char* B; int c;
    __device__ __forceinline__ bool next(int i, Unit& u) const {
        if (i > 0 || c >= 64) return false;
        u.pm = c >> 1; u.z = c & 1; u.pn = 0;
        u.a = A + ((size_t)u.pm * 256 * 4096 + u.z * 2048) * 2; u.b = B + ((size_t)24 * 256 * 4096 + u.z * 2048) * 2; return true; }
};
struct SchedQlat {
    const char* qbuf; const char* wuk; int G, c;
    __device__ __forceinline__ bool next(int i, Unit& u) const {
        const int L = i * G + xcd_run(c, G); if (L >= 2048) return false;
        u.z = L >> 6; u.pm = (L & 63) >> 1; u.pn = L & 1;
        u.a = qbuf + ((size_t)u.pm * 256 * 4096 + u.z * 128) * 2; u.b = wuk + ((size_t)u.z * 512 + u.pn * 256) * 128 * 2; return true; }
};
struct SchedIdx {
    const char* qidx; const char* kidx; int G, c;
    __device__ __forceinline__ bool next(int i, Unit& u) const {
        const int L = i * G + xcd_run(c, G); if (L >= 4 * 1120) return false;
        const int b = L / 1120, r = L % 1120 + 32; int j = 0;
#pragma unroll
        for (int t = 1; t < 8; ++t) if (r >= 16 * t * (t + 1)) j = t;
        const int rr = r - 16 * j * (j + 1), pml = 32 * j + rr / (j + 1); u.pn = rr % (j + 1); u.pm = b * 256 + pml; u.z = b;
        u.a = qidx + (size_t)u.pm * 8 * 4096 * 2; u.b = kidx + ((size_t)b * 2048 + u.pn * 256) * 128 * 2; return true; }
};
struct SchedOV {
    const char* olat; const char* wuv; int G, c;
    __device__ __forceinline__ bool next(int i, Unit& u) const {
        const int L = i * G + c; if (L >= 512) return false;
        u.pn = L >> 5; u.pm = L & 31; u.z = 0;
        u.a = olat + ((size_t)u.pm * 256 * QLD + u.pn * 1024) * 2; u.b = wuv + (size_t)u.pn * 256 * 1024 * 2; return true; }
};

struct ConvJob { const float* src; const float* gain; bf16_t* dst; int N, kt, nt, ldd, mode; };
struct ConvRegs { f32x4 v[2]; float g[2]; };
__device__ __forceinline__ void conv_load(const ConvJob& j, ConvRegs& r) {
    const int tid = threadIdx.x;
#pragma unroll
    for (int i = 0; i < 2; ++i) { const int row = (tid >> 4) + 32 * i, c4 = (tid & 15) * 4;
        r.v[i] = *(const f32x4*)(j.src + (size_t)(j.kt * 64 + row) * j.N + j.nt * 64 + c4); r.g[i] = j.gain ? j.gain[j.kt * 64 + row] : 1.f; }
}
#define CONV_BAR() do { asm volatile("s_waitcnt lgkmcnt(0)" ::: "memory"); __builtin_amdgcn_s_barrier(); asm volatile("" ::: "memory"); } while (0)
__device__ __forceinline__ void conv_store(LAS float* tile, const ConvJob& j, const ConvRegs& r) {
    const int tid = threadIdx.x, k0 = j.kt * 64, n0 = j.nt * 64;
    CONV_BAR();
#pragma unroll
    for (int i = 0; i < 2; ++i) { const int row = (tid >> 4) + 32 * i, c4 = (tid & 15) * 4; const f32x4 v = r.v[i] * r.g[i];
        LAS float* t = tile + row * 65 + c4; t[0] = v.x; t[1] = v.y; t[2] = v.z; t[3] = v.w; }
    CONV_BAR();
    const int n = tid >> 3, kc = (tid & 7) * 8; float f[8];
#pragma unroll
    for (int q = 0; q < 8; ++q) f[q] = tile[(kc + q) * 65 + n];
    u32x4 o; o.x = cvt_pk_bf16(f[0], f[1]); o.y = cvt_pk_bf16(f[2], f[3]); o.z = cvt_pk_bf16(f[4], f[5]); o.w = cvt_pk_bf16(f[6], f[7]);
    const int gn = n0 + n, gk = k0 + kc;
    if (j.mode == 0) *(u32x4*)(j.dst + (size_t)gn * j.ldd + gk) = o;
    else { const int h = gn >> 7, dv = gn & 127; bf16_t* rr = j.dst + ((size_t)(h >> 1) * 256 + (h & 1) * 128 + dv) * 1024;
        *(u32x4*)(rr + (h & 1) * 512 + gk) = o; *(u32x4*)(rr + ((h & 1) ^ 1) * 512 + gk) = (u32x4){0u, 0u, 0u, 0u}; }
}
__device__ __forceinline__ ConvJob conv_job_a(const Params& p, int t) {
    constexpr int T0 = 64 * 192, T1 = T0 + 16 * 16, T2 = T1 + 32 * 64; unsigned char* ws = p.ws; ConvJob j;
    if (t < T0)      { j = ConvJob{p.even_w_in, nullptr, (bf16_t*)(ws + OFF_WIN0), 12288, t / 192, t % 192, 4096, 0}; }
    else if (t < T1) { const int l = t - T0; j = ConvJob{p.glu_w, nullptr, (bf16_t*)(ws + OFF_WGLU), 1024, l / 16, l % 16, 1024, 0}; }
    else if (t < T2) { const int l = t - T1; j = ConvJob{p.even_w_out, nullptr, (bf16_t*)(ws + OFF_WOUT0), 4096, l / 64, l % 64, 2048, 0}; }
    else             { const int l = t - T2; j = ConvJob{p.odd_w_in, p.odd_norm, (bf16_t*)(ws + OFF_WIN1), ODD_IN, l / 99, l % 99, 4096, 0}; }
    return j;
}
__device__ __forceinline__ ConvJob conv_job_b(const Params& p, int t) {
    constexpr int T4 = 24 * 64, T5 = T4 + 24 * 64, T6 = T5 + 8 * 64; unsigned char* ws = p.ws; ConvJob j;
    if (t < T4)      { j = ConvJob{p.w_uq, p.q_norm, (bf16_t*)(ws + OFF_WQ), 4096, t / 64, t % 64, 1536, 0}; }
    else if (t < T5) { const int l = t - T4; j = ConvJob{p.w_iq, p.q_norm, (bf16_t*)(ws + OFF_WQ) + (size_t)4096 * 1536, 4096, l / 64, l % 64, 1536, 0}; }
    else if (t < T6) { const int l = t - T5; j = ConvJob{p.w_uv, nullptr, (bf16_t*)(ws + OFF_WUV), 4096, l / 64, l % 64, 512, 0}; }
    else             { const int l = t - T6; j = ConvJob{p.odd_w_out, nullptr, (bf16_t*)(ws + OFF_WOUT1), 4096, l / 64, l % 64, 4096, 0}; }
    return j;
}
template <bool PARTB>
__device__ __forceinline__ void conv_run(LAS unsigned char* lds, const Params& p, int first, int stride, int total) {
    if (first >= total) return;
    LAS float* tile = (LAS float*)lds;
    ConvJob cur = PARTB ? conv_job_b(p, first) : conv_job_a(p, first); ConvRegs rc; conv_load(cur, rc);
#pragma nounroll
    for (int t = first; t < total; t += stride) {
        const bool has_next = t + stride < total; const ConvJob nxt = PARTB ? conv_job_b(p, has_next ? t + stride : t) : conv_job_a(p, has_next ? t + stride : t);
        ConvRegs rn; if (has_next) conv_load(nxt, rn); else rn = rc;
        conv_store(tile, cur, rc);
        cur = nxt; rc = rn;
    }
}

__device__ __forceinline__ void phase0(LAS unsigned char* lds, const Params& p) {
    unsigned char* ws = p.ws; const int G = gridDim.x, bid = blockIdx.x, tid = threadIdx.x, lane = tid & 63, wid = tid >> 6;
    { bf16_t* h0 = (bf16_t*)(ws + OFF_B);
      for (int row = bid * 8 + wid; row < NTOK; row += G * 8) { const float* xr = p.x + (size_t)row * DM; f32x4 v[16]; float ss = 0.f;
#pragma unroll
          for (int i = 0; i < 16; ++i) { v[i] = *(const f32x4*)(xr + (i * 64 + lane) * 4); ss += v[i].x * v[i].x + v[i].y * v[i].y + v[i].z * v[i].z + v[i].w * v[i].w; }
          ss = wave_sum(ss); const float rs = rsqrtf(ss * (1.f / DM) + EPS);
#pragma unroll
          for (int i = 0; i < 16; ++i) { const f32x4 g = *(const f32x4*)(p.even_norm + (i * 64 + lane) * 4); *(u32x2*)(h0 + (size_t)row * DM + (i * 64 + lane) * 4) = pack4(v[i] * rs * g); } } }
    { float2* tab = (float2*)(ws + OFF_ROPE);
      for (int i = bid * 512 + tid; i < 2048 * 16; i += G * 512) { const int pos = i >> 4, j = i & 15; const float inv = powf(500000.f, -(float)(2 * j) / 32.f); const float ang = (float)pos * inv; tab[i] = make_float2(cosf(ang), sinf(ang)); } }
    { u32x4* d = (u32x4*)(ws + OFF_WIN1 + (size_t)ODD_IN * 4096 * 2);
      for (int i = bid * 512 + tid; i < 64 * 4096 * 2 / 16; i += G * 512) d[i] = (u32x4){0u, 0u, 0u, 0u}; }
    conv_run<false>(lds, p, bid, G, 64 * 192 + 16 * 16 + 32 * 64 + 64 * 99);
}

__device__ __forceinline__ void phase0b(LAS unsigned char* lds, const Params& p, int rank, int n) {
    unsigned char* ws = p.ws; const int tid = threadIdx.x;
    { bf16_t* d = (bf16_t*)(ws + OFF_WUK);
      for (int i = rank * 512 + tid; i < 32 * 512 * 16; i += n * 512) { const int kc = i & 15, c = (i >> 4) & 511, h = i >> 13; u32x4 o = (u32x4){0u, 0u, 0u, 0u};
          if (kc >= 4) { const float* sp = p.w_uk + ((size_t)c * 32 + h) * 96 + (kc - 4) * 8; const f32x4 a = *(const f32x4*)sp * ATT_SCALE, b = *(const f32x4*)(sp + 4) * ATT_SCALE;
              o.x = cvt_pk_bf16(a.x, a.y); o.y = cvt_pk_bf16(a.z, a.w); o.z = cvt_pk_bf16(b.x, b.y); o.w = cvt_pk_bf16(b.z, b.w); }
          *(u32x4*)(d + ((size_t)h * 512 + c) * 128 + kc * 8) = o; } }
    conv_run<true>(lds, p, rank, n, 24 * 64 + 24 * 64 + 8 * 64 + 64 * 64);
}

__device__ __forceinline__ void s5_item(LAS unsigned char* lds, const Params& p, int item) {
    const int b = item >> 6, g = item & 63, tid = threadIdx.x, lane = tid & 63, wid = tid >> 6, l15 = lane & 15, q4 = lane >> 4;
    const bf16_t* proj0 = (const bf16_t*)(p.ws + OFF_A); bf16_t* ybuf = (bf16_t*)(p.ws + OFF_YBUF);
    LAS unsigned char* u_s = lds;
    LAS unsigned char* W_s = lds + 65536 + wid * 8448;
    LAS float* carry = (LAS float*)(lds + 65536 + 8 * 8448);
    LAS float* cst = carry + 1024;
    __syncthreads();
    for (int i = tid; i < 4096; i += 512) { const int t = i >> 1, hf = i & 1; *(LAS u32x4*)(u_s + t * 32 + hf * 16) = *(const u32x4*)(proj0 + (size_t)(b * SEQ + t) * EVEN_IN + g * 16 + hf * 8); }
    const int gp = g * 64 + lane;
    const float lr = fminf(p.lam_re[gp], -1e-4f), li = p.lam_im[gp], dt = expf(p.log_step[g]);
    const float mag = expf(lr * dt), ar = mag * cosf(li * dt), ai = mag * sinf(li * dt);
    { const float den = lr * lr + li * li, nr = ar - 1.f, ni = ai;
      if (wid == 0) { cst[lane * 4] = ar; cst[lane * 4 + 1] = ai; cst[lane * 4 + 2] = (nr * lr + ni * li) / den; cst[lane * 4 + 3] = (ni * lr - nr * li) / den; } }
    bf16x8 cf[4];
#pragma unroll
    for (int kb = 0; kb < 4; ++kb) { const float* sp = (kb < 2 ? p.c_re : p.c_im) + ((size_t)g * 16 + l15) * 64 + (kb & 1) * 32 + 8 * q4; const float sg = kb < 2 ? 1.f : -1.f;
        const f32x4 a = *(const f32x4*)sp * sg, c = *(const f32x4*)(sp + 4) * sg; u32x4 o; o.x = cvt_pk_bf16(a.x, a.y); o.y = cvt_pk_bf16(a.z, a.w); o.z = cvt_pk_bf16(c.x, c.y); o.w = cvt_pk_bf16(c.z, c.w);
        cf[kb] = __builtin_bit_cast(bf16x8, o); }
    const float dsk = p.s5_d[g * 16 + l15];
    __syncthreads();
    bf16x8 bre[4], bim[4];
#pragma unroll
    for (int pt = 0; pt < 4; ++pt) { const int ps = 16 * pt + l15; const float cr = cst[ps * 4 + 2], ci = cst[ps * 4 + 3];
        const float* br = p.b_re + ((size_t)g * 64 + ps) * 16 + (q4 & 1) * 8; const float* bi = p.b_im + ((size_t)g * 64 + ps) * 16 + (q4 & 1) * 8;
        const f32x4 r0 = *(const f32x4*)br, r1 = *(const f32x4*)(br + 4), i0 = *(const f32x4*)bi, i1 = *(const f32x4*)(bi + 4);
        float vr[8], vi[8];
#pragma unroll
        for (int e = 0; e < 4; ++e) { vr[e] = cr * r0[e] - ci * i0[e]; vi[e] = cr * i0[e] + ci * r0[e]; vr[4 + e] = cr * r1[e] - ci * i1[e]; vi[4 + e] = cr * i1[e] + ci * r1[e]; }
        if (q4 >= 2) {
#pragma unroll
            for (int e = 0; e < 8; ++e) { vr[e] -= bf2f((bf16_t)(cvt_pk_bf16(vr[e], 0.f) & 0xffffu)); vi[e] -= bf2f((bf16_t)(cvt_pk_bf16(vi[e], 0.f) & 0xffffu)); } }
        u32x4 o; o.x = cvt_pk_bf16(vr[0], vr[1]); o.y = cvt_pk_bf16(vr[2], vr[3]); o.z = cvt_pk_bf16(vr[4], vr[5]); o.w = cvt_pk_bf16(vr[6], vr[7]); bre[pt] = __builtin_bit_cast(bf16x8, o);
        o.x = cvt_pk_bf16(vi[0], vi[1]); o.y = cvt_pk_bf16(vi[2], vi[3]); o.z = cvt_pk_bf16(vi[4], vi[5]); o.w = cvt_pk_bf16(vi[6], vi[7]); bim[pt] = __builtin_bit_cast(bf16x8, o); }
    const int t0 = wid * 256;
#define S5_BU(tb) { const bf16x8 ua = *(const LAS bf16x8*)(u_s + ((tb) + l15) * 32 + (q4 & 1) * 16); \
        _Pragma("unroll") for (int pt = 0; pt < 4; ++pt) { const f32x4 z4 = (f32x4){0.f, 0.f, 0.f, 0.f}; \
            const f32x4 dr = __builtin_amdgcn_mfma_f32_16x16x32_bf16(ua, bre[pt], z4, 0, 0, 0), di = __builtin_amdgcn_mfma_f32_16x16x32_bf16(ua, bim[pt], z4, 0, 0, 0); \
            _Pragma("unroll") for (int i = 0; i < 4; ++i) { *(LAS float*)(W_s + (4 * q4 + i) * 528 + (16 * pt + l15) * 4) = dr[i]; *(LAS float*)(W_s + (4 * q4 + i) * 528 + 256 + (16 * pt + l15) * 4) = di[i]; } } \
        __builtin_amdgcn_wave_barrier(); }
    float sr = 0.f, si = 0.f;
    for (int sc = 0; sc < 16; ++sc) { S5_BU(t0 + sc * 16)
#pragma unroll
        for (int tt = 0; tt < 16; ++tt) { const float br_ = *(const LAS float*)(W_s + tt * 528 + lane * 4), bi_ = *(const LAS float*)(W_s + tt * 528 + 256 + lane * 4);
            const float nsr = ar * sr - ai * si + br_, nsi = ar * si + ai * sr + bi_; sr = nsr; si = nsi; }
        __builtin_amdgcn_wave_barrier(); }
    carry[(wid * 64 + lane) * 2] = sr; carry[(wid * 64 + lane) * 2 + 1] = si;
    __syncthreads();
    float pr = ar, pi = ai;
#pragma unroll
    for (int i = 0; i < 8; ++i) { const float nr2 = pr * pr - pi * pi, ni2 = 2.f * pr * pi; pr = nr2; pi = ni2; }
    sr = 0.f; si = 0.f;
    for (int v = 0; v < wid; ++v) { const float er = carry[(v * 64 + lane) * 2], ei = carry[(v * 64 + lane) * 2 + 1]; const float nsr = pr * sr - pi * si + er, nsi = pr * si + pi * sr + ei; sr = nsr; si = nsi; }
    for (int sc = 0; sc < 16; ++sc) { S5_BU(t0 + sc * 16)
#pragma unroll
        for (int tt = 0; tt < 16; ++tt) { const float br_ = *(const LAS float*)(W_s + tt * 528 + lane * 4), bi_ = *(const LAS float*)(W_s + tt * 528 + 256 + lane * 4);
            const float nsr = ar * sr - ai * si + br_, nsi = ar * si + ai * sr + bi_; sr = nsr; si = nsi;
            const unsigned pk = cvt_pk_bf16(sr, si);
            *(LAS bf16_t*)(W_s + tt * 528 + lane * 2) = (bf16_t)(pk & 0xffffu); *(LAS bf16_t*)(W_s + tt * 528 + 128 + lane * 2) = (bf16_t)(pk >> 16); }
        __builtin_amdgcn_wave_barrier();
        f32x4 acc = (f32x4){0.f, 0.f, 0.f, 0.f};
#pragma unroll
        for (int kb = 0; kb < 4; ++kb) { const bf16x8 a = *(const LAS bf16x8*)(W_s + l15 * 528 + kb * 64 + q4 * 16); acc = __builtin_amdgcn_mfma_f32_16x16x32_bf16(a, cf[kb], acc, 0, 0, 0); }
        __builtin_amdgcn_wave_barrier();
#pragma unroll
        for (int i = 0; i < 4; ++i) { const int t = t0 + sc * 16 + 4 * q4 + i; const float uv = bf2f(*(const LAS bf16_t*)(u_s + t * 32 + l15 * 2));
            const float yv = acc[i] + dsk * uv; const float z = 0.7978845608028654f * (yv + 0.044715f * yv * yv * yv); const float th = 1.f - 2.f / (__expf(2.f * z) + 1.f);
            const float gl = 0.5f * yv * (1.f + th);
            ybuf[(size_t)(b * SEQ + t) * 1024 + g * 16 + l15] = (bf16_t)(cvt_pk_bf16(gl, 0.f) & 0xffffu); }
    }
#undef S5_BU
}

__device__ __forceinline__ void dil_item(LAS unsigned char* lds, const Params& p, int item) {
    const int tid = threadIdx.x, lane = tid & 63, w = __builtin_amdgcn_readfirstlane(tid >> 6), l15 = lane & 15, q4 = lane >> 4;
    const int bh = item / 48, r48 = item % 48, b = bh >> 3, h = bh & 7, g = r48 >> 4, j = r48 & 15;
    const int dil = g == 0 ? 1 : (g == 1 ? 4 : 16), cls = j % dil, blk = j / dil, q0 = blk * 128;
    const bf16_t* proj0 = (const bf16_t*)(p.ws + OFF_A);
    const int qcol = 2048 + g * 3072 + h * 128, kcol = qcol + 1024, vcol = qcol + 2048;
    LAS unsigned char* Ks = lds; LAS unsigned char* Vs = lds + 128 * 288;
    const int qi = q0 + 16 * w + l15;
    bf16x8 qf[4];
    { const bf16_t* qp = proj0 + (size_t)(b * SEQ + cls + dil * qi) * EVEN_IN + qcol + 8 * q4;
#pragma unroll
      for (int ks = 0; ks < 4; ++ks) qf[ks] = *(const bf16x8*)(qp + 32 * ks); }
    float mrun = -INFINITY, lsum = 0.f; f32x4 O[8];
#pragma unroll
    for (int d = 0; d < 8; ++d) O[d] = (f32x4){0.f, 0.f, 0.f, 0.f};
    for (int half = (blk == 0 ? 1 : 0); half < 2; ++half) {
        const int kbase = q0 - 128 + 128 * half;
        __syncthreads();
#pragma unroll
        for (int i = 0; i < 4; ++i) { const int pc = tid + 512 * i, row = pc >> 4, ch = pc & 15; const bf16_t* src = proj0 + (size_t)(b * SEQ + cls + dil * (kbase + row)) * EVEN_IN + ch * 8;
            *(LAS u32x4*)(Ks + row * 288 + ch * 16) = *(const u32x4*)(src + kcol); *(LAS u32x4*)(Vs + row * 288 + ch * 16) = *(const u32x4*)(src + vcol); }
        __syncthreads();
        f32x4 S[8]; float mx = -INFINITY;
#pragma unroll
        for (int kt = 0; kt < 8; ++kt) { f32x4 a = (f32x4){-INFINITY, -INFINITY, -INFINITY, -INFINITY};
            if (half ? (kt <= w) : (kt >= w)) { a = (f32x4){0.f, 0.f, 0.f, 0.f};
#pragma unroll
                for (int ks = 0; ks < 4; ++ks) { const bf16x8 kf = *(const LAS bf16x8*)(Ks + (16 * kt + l15) * 288 + ks * 64 + q4 * 16); a = __builtin_amdgcn_mfma_f32_16x16x32_bf16(kf, qf[ks], a, 0, 0, 0); }
#pragma unroll
                for (int i = 0; i < 4; ++i) { const int dist = qi - (kbase + 16 * kt + 4 * q4 + i); a[i] = (dist >= 0 && dist <= 128) ? a[i] : -INFINITY; mx = fmaxf(mx, a[i]); } }
            S[kt] = a; }
        mx = max_xor32(max_xor16(mx));
        const float mnew = fmaxf(mrun, mx), alpha = exp2f(mrun - mnew); mrun = mnew; lsum *= alpha;
#pragma unroll
        for (int d = 0; d < 8; ++d) O[d] = O[d] * alpha;
#pragma unroll
        for (int kt = 0; kt < 8; ++kt)
#pragma unroll
            for (int i = 0; i < 4; ++i) { const float pv = exp2f(S[kt][i] - mnew); S[kt][i] = pv; lsum += pv; }
#pragma unroll
        for (int s = 0; s < 4; ++s) if (half ? (2 * s <= w) : (2 * s + 1 >= w)) { u32x4 pk; pk.x = cvt_pk_bf16(S[2 * s][0], S[2 * s][1]); pk.y = cvt_pk_bf16(S[2 * s][2], S[2 * s][3]); pk.z = cvt_pk_bf16(S[2 * s + 1][0], S[2 * s + 1][1]); pk.w = cvt_pk_bf16(S[2 * s + 1][2], S[2 * s + 1][3]);
            const bf16x8 pf = __builtin_bit_cast(bf16x8, pk);
#pragma unroll
            for (int d = 0; d < 8; ++d) {
                LAS unsigned char* va = Vs + (32 * s + 4 * q4 + (l15 >> 2)) * 288 + (16 * d + 4 * (l15 & 3)) * 2;
                const s16x4 t0 = __builtin_amdgcn_ds_read_tr16_b64_v4i16((LAS s16x4*)va), t1 = __builtin_amdgcn_ds_read_tr16_b64_v4i16((LAS s16x4*)(va + 16 * 288));
                const bf16x8 vf = __builtin_shufflevector(t0, t1, 0, 1, 2, 3, 4, 5, 6, 7);
                O[d] = __builtin_amdgcn_mfma_f32_16x16x32_bf16(vf, pf, O[d], 0, 0, 0); } }
    }
    lsum = sum_xor32(sum_xor16(lsum));
    const float inv = 1.f / lsum; const size_t tok = (size_t)b * SEQ + cls + dil * qi;
    bf16_t* ob = (bf16_t*)(p.ws + OFF_OBUF) + ((size_t)g * NTOK + tok) * 1024 + h * 128 + 4 * q4;
#pragma unroll
    for (int d = 0; d < 8; ++d) *(u32x2*)(ob + 16 * d) = pack4(O[d] * inv);
    if (q4 == 0) ((float*)(p.ws + OFF_LSE))[((size_t)g * NTOK + tok) * 8 + h] = mrun + log2f(lsum);
}

__device__ __forceinline__ void merge_rows(const Params& p, int first, int stride) {
    const bf16_t* __restrict__ obuf = (const bf16_t*)(p.ws + OFF_OBUF); const float* __restrict__ lse = (const float*)(p.ws + OFF_LSE); const bf16_t* __restrict__ proj0 = (const bf16_t*)(p.ws + OFF_A); bf16_t* __restrict__ mix = (bf16_t*)(p.ws + OFF_MIX);
    const int c = threadIdx.x, h = c >> 6;
    for (int tok0 = first; tok0 < NTOK; tok0 += 4 * stride) {
        float l[4][3]; unsigned o[4][3], zb[4];
#pragma unroll
        for (int u = 0; u < 4; ++u) { const int tok = tok0 + u * stride; if (tok < NTOK) {
#pragma unroll
            for (int g = 0; g < 3; ++g) { l[u][g] = lse[((size_t)g * NTOK + tok) * 8 + h]; o[u][g] = *(const unsigned*)(obuf + ((size_t)g * NTOK + tok) * 1024 + 2 * c); }
            zb[u] = *(const unsigned*)(proj0 + (size_t)tok * EVEN_IN + 11264 + 2 * c); } }
#pragma unroll
        for (int u = 0; u < 4; ++u) { const int tok = tok0 + u * stride; if (tok < NTOK) {
            const float mx = fmaxf(l[u][0], fmaxf(l[u][1], l[u][2])), e0 = exp2f(l[u][0] - mx), e1 = exp2f(l[u][1] - mx), e2 = exp2f(l[u][2] - mx), inv = 1.f / (e0 + e1 + e2);
            const float a = (e0 * bflo(o[u][0]) + e1 * bflo(o[u][1]) + e2 * bflo(o[u][2])) * inv * silu_f(bflo(zb[u])), bq = (e0 * bfhi(o[u][0]) + e1 * bfhi(o[u][1]) + e2 * bfhi(o[u][2])) * inv * silu_f(bfhi(zb[u]));
            *(unsigned*)(mix + (size_t)tok * 2048 + 1024 + 2 * c) = cvt_pk_bf16(a, bq); } }
    }
}

__device__ __forceinline__ void phase7(LAS unsigned char* lds, const Params& p) {
    const int lane = threadIdx.x & 63, wid = threadIdx.x >> 6;
    const bf16_t* proj1 = (const bf16_t*)(p.ws + OFF_PROJ1); bf16_t* ckv = (bf16_t*)(p.ws + OFF_CKV); bf16_t* kidx = (bf16_t*)(p.ws + OFF_KIDX);
    float* widx = (float*)(p.ws + OFF_WIDX); float* rsq = (float*)(p.ws + OFF_RSQ); const float2* rope = (const float2*)(p.ws + OFF_ROPE);
    float kmaxw = 0.f;
    for (int row = blockIdx.x * 8 + wid; row < NTOK; row += gridDim.x * 8) { const bf16_t* pr = proj1 + (size_t)row * ODD_INP; const int pos = row & 2047;
        float ss = 0.f, kn2 = 0.f;
#pragma unroll
        for (int i = 0; i < 3; ++i) { const u32x4 v = *(const u32x4*)(pr + (i * 64 + lane) * 8);
            ss += bflo(v.x) * bflo(v.x) + bfhi(v.x) * bfhi(v.x) + bflo(v.y) * bflo(v.y) + bfhi(v.y) * bfhi(v.y) + bflo(v.z) * bflo(v.z) + bfhi(v.z) * bfhi(v.z) + bflo(v.w) * bflo(v.w) + bfhi(v.w) * bfhi(v.w); }
        ss = wave_sum(ss); if (lane == 0) rsq[row] = rsqrtf(ss * (1.f / 1536.f) + EPS);
        { const u32x4 v = *(const u32x4*)(pr + 1536 + lane * 8); float f[8] = {bflo(v.x), bfhi(v.x), bflo(v.y), bfhi(v.y), bflo(v.z), bfhi(v.z), bflo(v.w), bfhi(v.w)}; float s2 = 0.f;
#pragma unroll
          for (int e = 0; e < 8; ++e) s2 += f[e] * f[e];
          s2 = wave_sum(s2); const float r = rsqrtf(s2 * (1.f / 512.f) + EPS); const f32x4 g0 = *(const f32x4*)(p.kv_norm + lane * 8), g1 = *(const f32x4*)(p.kv_norm + lane * 8 + 4);
          u32x4 o; o.x = cvt_pk_bf16(f[0] * r * g0.x, f[1] * r * g0.y); o.y = cvt_pk_bf16(f[2] * r * g0.z, f[3] * r * g0.w); o.z = cvt_pk_bf16(f[4] * r * g1.x, f[5] * r * g1.y); o.w = cvt_pk_bf16(f[6] * r * g1.z, f[7] * r * g1.w);
          *(u32x4*)(ckv + (size_t)row * KVLD + lane * 8) = o;
          float k2 = 0.f;
#pragma unroll
          for (int e = 0; e < 4; ++e) { const float a0 = f[e] * r * g0[e], a1 = f[4 + e] * r * g1[e]; k2 += a0 * a0 + a1 * a1; }
          kn2 = k2; }
        {
          const float v = bf2f(pr[2048 + (lane & 31)]); const float o = __shfl_xor(v, 16); const float2 cs = rope[pos * 16 + (lane & 15)];
          const float r = (lane & 16) ? (v * cs.x + o * cs.y) : (v * cs.x - o * cs.y);
          if (lane < 32) { ckv[(size_t)row * KVLD + 512 + lane] = (bf16_t)(cvt_pk_bf16(r, 0.f) & 0xffffu); kn2 += r * r; }
          kn2 = wave_sum(kn2); kmaxw = fmaxf(kmaxw, kn2); }
        {
          const float a = bf2f(pr[2080 + lane]), c = bf2f(pr[2080 + 64 + lane]); const float s2 = wave_sum(a * a + c * c); const float r = rsqrtf(s2 * (1.f / 128.f) + EPS);
          float an = a * r * p.idx_k_norm[lane]; const float cn = c * r * p.idx_k_norm[64 + lane];
          const float o = __shfl_xor(an, 16); const float2 cs = rope[pos * 16 + (lane & 15)];
          if (lane < 32) an = (lane & 16) ? (an * cs.x + o * cs.y) : (an * cs.x - o * cs.y);
          kidx[(size_t)row * 128 + lane] = (bf16_t)(cvt_pk_bf16(an, 0.f) & 0xffffu); kidx[(size_t)row * 128 + 64 + lane] = (bf16_t)(cvt_pk_bf16(cn, 0.f) & 0xffffu); }
        if (lane < 32) widx[(size_t)row * 32 + lane] = bf2f(pr[2208 + lane]) * (0.08838834764831845f * 0.17677669529663687f);
    }
    LAS float* red = (LAS float*)lds;
    __syncthreads();
    if (lane == 0) red[wid] = kmaxw;
    __syncthreads();
    if (threadIdx.x == 0) { float m = red[0];
#pragma unroll
        for (int i = 1; i < 8; ++i) m = fmaxf(m, red[i]);
        atomicMax((int*)(p.ws + OFF_BAR), __float_as_int(m * 1.02f)); }
}

__device__ __forceinline__ unsigned fkey(float f) { const unsigned u = __float_as_uint(f); return (u & 0x80000000u) ? ~u : (u | 0x80000000u); }
__device__ __forceinline__ void topk_pair(const Params& p, int tokA, int tokB) {
    const int lane = threadIdx.x & 63; const bool two = tokB >= 0; if (!two) tokB = tokA;
    const int qp[2] = {tokA & 2047, tokB & 2047};
    const float* sc[2] = {(const float*)(p.ws + OFF_ISC) + (size_t)tokA * 2048, (const float*)(p.ws + OFF_ISC) + (size_t)tokB * 2048};
    bf16_t* sel[2] = {(bf16_t*)(p.ws + OFF_SEL) + (size_t)tokA * 256, (bf16_t*)(p.ws + OFF_SEL) + (size_t)tokB * 256};
    unsigned key[2][32];
#pragma unroll
    for (int q = 0; q < 2; ++q)
#pragma unroll
        for (int i = 0; i < 32; ++i) { const int idx = i * 64 + lane; key[q][i] = idx <= qp[q] ? fkey(sc[q][idx <= qp[q] ? idx : 0]) : 0u; }
    unsigned T[2] = {0u, 0u}; bool ex[2] = {false, false};
    for (int bit = 31; bit >= 0; --bit) {
        if (ex[0] && ex[1]) break;
        const unsigned c0 = T[0] | (1u << bit), c1 = T[1] | (1u << bit); unsigned cnt = 0u;
#pragma unroll
        for (int i = 0; i < 32; ++i) { cnt += (key[0][i] >= c0) ? 1u : 0u; cnt += (key[1][i] >= c1) ? 0x10000u : 0u; }
        cnt += (unsigned)__builtin_amdgcn_update_dpp(0, (int)cnt, 0xB1, 0xf, 0xf, false);
        cnt += (unsigned)__builtin_amdgcn_update_dpp(0, (int)cnt, 0x4E, 0xf, 0xf, false);
        cnt += (unsigned)__builtin_amdgcn_update_dpp(0, (int)cnt, 0x141, 0xf, 0xf, false);
        cnt += (unsigned)__builtin_amdgcn_update_dpp(0, (int)cnt, 0x140, 0xf, 0xf, false);
        { typedef unsigned u32x2p __attribute__((ext_vector_type(2)));
          u32x2p r = __builtin_amdgcn_permlane16_swap(cnt, cnt, false, false); cnt = r.x + r.y;
          r = __builtin_amdgcn_permlane32_swap(cnt, cnt, false, false); cnt = r.x + r.y; }
        cnt = (unsigned)__builtin_amdgcn_readfirstlane((int)cnt);
        const int n0 = (int)(cnt & 0xffffu), n1 = (int)(cnt >> 16);
        if (!ex[0]) { if (n0 >= 256) T[0] = c0; if (n0 == 256) ex[0] = true; }
        if (!ex[1]) { if (n1 >= 256) T[1] = c1; if (n1 == 256) ex[1] = true; }
    }
#pragma unroll
    for (int q = 0; q < 2; ++q) { if (q == 1 && !two) break;
        int base = 0;
#pragma unroll
        for (int i = 0; i < 32; ++i) { const bool pr = ex[q] ? key[q][i] >= T[q] : key[q][i] > T[q]; const unsigned long long mk = __ballot(pr); const int pos = base + __builtin_amdgcn_mbcnt_hi((unsigned)(mk >> 32), __builtin_amdgcn_mbcnt_lo((unsigned)mk, 0u));
            if (pr) sel[q][pos] = (bf16_t)(i * 64 + lane); base += __popcll(mk); }
        if (!ex[q])
#pragma unroll
        for (int i = 0; i < 32; ++i) { const bool pr = key[q][i] == T[q]; const unsigned long long mk = __ballot(pr); const int pos = base + __builtin_amdgcn_mbcnt_hi((unsigned)(mk >> 32), __builtin_amdgcn_mbcnt_lo((unsigned)mk, 0u));
            if (pr && pos < 256) sel[q][pos] = (bf16_t)(i * 64 + lane); base += __popcll(mk); } }
}
__device__ __forceinline__ void topk_phase(const Params& p) {
    const int lane = threadIdx.x & 63, wid = threadIdx.x >> 6, G = gridDim.x, bid = blockIdx.x;
    const int nq = (NTOK - bid + G - 1) / G;
    int mine[4]; int nm = 0;
    int k = 0;
    for (int j = 0; j < nq; ++j) { const int token = bid + G * j, qpos = token & 2047;
        if (qpos < 256) { if ((j & 7) == wid) { bf16_t* sel = (bf16_t*)(p.ws + OFF_SEL) + (size_t)token * 256; for (int i = lane; i <= qpos; i += 64) sel[i] = (bf16_t)i; } }
        else { if ((k & 7) == wid && nm < 4) { if (nm == 0) mine[0] = token; else if (nm == 1) mine[1] = token; else if (nm == 2) mine[2] = token; else mine[3] = token; ++nm; } else if ((k & 7) == wid) topk_pair(p, token, -1); ++k; } }
    if (nm >= 2) topk_pair(p, mine[0], mine[1]); else if (nm == 1) topk_pair(p, mine[0], -1);
    if (nm >= 4) topk_pair(p, mine[2], mine[3]); else if (nm == 3) topk_pair(p, mine[2], -1);
}


#define LDSRD4(k0, k1, k2, k3, addr, o0, o1, o2, o3) asm volatile("ds_read_b128 %0, %4 offset:%5\n\tds_read_b128 %1, %4 offset:%6\n\tds_read_b128 %2, %4 offset:%7\n\tds_read_b128 %3, %4 offset:%8\n\ts_waitcnt lgkmcnt(0)" \
        : "=&v"(k0), "=&v"(k1), "=&v"(k2), "=&v"(k3) : "v"(addr), "n"(o0), "n"(o1), "n"(o2), "n"(o3) : "memory")
#define LDSRD2(k0, k1, addr, o0, o1) asm volatile("ds_read_b128 %0, %2 offset:%3\n\tds_read_b128 %1, %2 offset:%4\n\ts_waitcnt lgkmcnt(0)" : "=&v"(k0), "=&v"(k1) : "v"(addr), "n"(o0), "n"(o1) : "memory")
#define LDSRD1(k0, addr, o0) asm volatile("ds_read_b128 %0, %1 offset:%2\n\ts_waitcnt lgkmcnt(0)" : "=&v"(k0) : "v"(addr), "n"(o0) : "memory")
__device__ __forceinline__ void lds_rd_mx8(float (&m)[8], unsigned addr) {
    asm volatile("ds_read_b32 %0, %8\n\tds_read_b32 %1, %8 offset:128\n\tds_read_b32 %2, %8 offset:256\n\tds_read_b32 %3, %8 offset:384\n\t"
                 "ds_read_b32 %4, %8 offset:64\n\tds_read_b32 %5, %8 offset:192\n\tds_read_b32 %6, %8 offset:320\n\tds_read_b32 %7, %8 offset:448\n\ts_waitcnt lgkmcnt(0)"
                 : "=&v"(m[0]), "=&v"(m[1]), "=&v"(m[2]), "=&v"(m[3]), "=&v"(m[4]), "=&v"(m[5]), "=&v"(m[6]), "=&v"(m[7]) : "v"(addr) : "memory");
}
#define LDSRD_PV(p0, p1, t, pb, vb, PO, VO) asm volatile("ds_read_b128 %0, %10 offset:%12\n\tds_read_b128 %1, %10 offset:%13\n\t" \
        "ds_read_b64_tr_b16 %2, %11 offset:%14\n\tds_read_b64_tr_b16 %3, %11 offset:%15\n\tds_read_b64_tr_b16 %4, %11 offset:%16\n\tds_read_b64_tr_b16 %5, %11 offset:%17\n\t" \
        "ds_read_b64_tr_b16 %6, %11 offset:%18\n\tds_read_b64_tr_b16 %7, %11 offset:%19\n\tds_read_b64_tr_b16 %8, %11 offset:%20\n\tds_read_b64_tr_b16 %9, %11 offset:%21\n\ts_waitcnt lgkmcnt(0)" \
        : "=&v"(p0), "=&v"(p1), "=&v"(t[0]), "=&v"(t[1]), "=&v"(t[2]), "=&v"(t[3]), "=&v"(t[4]), "=&v"(t[5]), "=&v"(t[6]), "=&v"(t[7]) \
        : "v"(pb), "v"(vb), "n"(PO), "n"((PO) + 2304), "n"(VO), "n"((VO) + 4416), "n"((VO) + 32), "n"((VO) + 32 + 4416), "n"((VO) + 64), "n"((VO) + 64 + 4416), "n"((VO) + 96), "n"((VO) + 96 + 4416) : "memory")
#define LDSRD_PVA(p0, p1, t, pb, vb, PO, VO) asm volatile("ds_read_b128 %0, %6 offset:%8\n\tds_read_b128 %1, %6 offset:%9\n\t" \
        "ds_read_b64_tr_b16 %2, %7 offset:%10\n\tds_read_b64_tr_b16 %3, %7 offset:%11\n\tds_read_b64_tr_b16 %4, %7 offset:%12\n\tds_read_b64_tr_b16 %5, %7 offset:%13\n\ts_waitcnt lgkmcnt(0)" \
        : "=&v"(p0), "=&v"(p1), "=&v"(t[0]), "=&v"(t[1]), "=&v"(t[2]), "=&v"(t[3]) \
        : "v"(pb), "v"(vb), "n"(PO), "n"((PO) + 2304), "n"(VO), "n"((VO) + 4416), "n"((VO) + 32), "n"((VO) + 32 + 4416) : "memory")
#define LDSRD_PVB(t, vb, VO) asm volatile("ds_read_b64_tr_b16 %0, %4 offset:%5\n\tds_read_b64_tr_b16 %1, %4 offset:%6\n\tds_read_b64_tr_b16 %2, %4 offset:%7\n\tds_read_b64_tr_b16 %3, %4 offset:%8\n\ts_waitcnt lgkmcnt(0)" \
        : "=&v"(t[0]), "=&v"(t[1]), "=&v"(t[2]), "=&v"(t[3]) : "v"(vb), "n"((VO) + 64), "n"((VO) + 64 + 4416), "n"((VO) + 96), "n"((VO) + 96 + 4416) : "memory")
#define WG_BAR() do { asm volatile("s_waitcnt lgkmcnt(0)" ::: "memory"); __builtin_amdgcn_s_barrier(); asm volatile("" ::: "memory"); } while (0)
__device__ __forceinline__ void dsa_phase(LAS unsigned char* lds, const Params& p, bool do_write) {
    const int tid = threadIdx.x, lane = tid & 63, w = tid >> 6, l15 = lane & 15, q4 = lane >> 4, kt = w & 3, ht = w >> 2;
    const int G = gridDim.x, bid = blockIdx.x;
    const int nq = (NTOK - bid + G - 1) / G;
    if (nq <= 0) return;
    LAS unsigned char* Pl = lds + 141312;
    LAS float* mxs = (LAS float*)(lds + 145920);
    LAS float* lred = mxs + 128;
    LAS int* sels = (LAS int*)(lds + 146944);
    const bf16_t* selg = (const bf16_t*)(p.ws + OFF_SEL);
    const float kmax2 = __int_as_float(__hip_atomic_load((const int*)(p.ws + OFF_BAR), __ATOMIC_RELAXED, __HIP_MEMORY_SCOPE_AGENT));
    unsigned gpk[5] = {0u, 0u, 0u, 0u, 0u};
#pragma unroll
    for (int i = 0; i < 9; ++i) { const int q = w + 8 * i, pc = 64 * q + lane, row = q < 69 ? pc / 69 : 0, col = pc - row * 69; gpk[i >> 1] |= ((unsigned)row | ((unsigned)(col < 68 ? col : 0) << 6)) << (16 * (i & 1)); }
#define GATHER_DMA(ckvb, selbase, buf) { _Pragma("unroll") for (int i = 0; i < 9; ++i) { const int q = w + 8 * i; if (q < 69) { unsigned gw = gpk[i >> 1]; asm volatile("" : "+v"(gw)); const unsigned ge = (gw >> (16 * (i & 1))) & 0xffffu; \
        const int idx = sels[(selbase) + (int)(ge & 63u)]; const unsigned char* gsrc = (ckvb) + (size_t)idx * (KVLD * 2) + ((ge >> 6) << 4); \
        __builtin_amdgcn_global_load_lds((const unsigned*)gsrc, (LAS unsigned*)((buf) + q * 1024), 16, 0, 0); } } }
#define DMA_WAIT() asm volatile("s_waitcnt vmcnt(0)" ::: "memory")
    const unsigned sa0 = (unsigned)(size_t)(lds + (16 * kt + l15) * 1104 + q4 * 16);
    const unsigned va0 = (unsigned)(size_t)(lds + (8 * q4 + (l15 >> 2)) * 1104 + (64 * w + 4 * (l15 & 3)) * 2);
    const unsigned pa0 = (unsigned)(size_t)(Pl + l15 * 144 + q4 * 16);
    const unsigned ma0 = (unsigned)(size_t)((LAS unsigned char*)mxs + l15 * 4);
    bf16x8 qf[17];
    { const int token = bid, qpos = token & 2047, cnt = qpos + 1 < 256 ? qpos + 1 : 256;
      if (tid < 256) sels[tid] = tid < cnt ? (int)selg[(size_t)token * 256 + tid] : 0;
      const bf16_t* qp = (const bf16_t*)(p.ws + OFF_D) + (size_t)token * QLD + (16 * ht + l15) * 544 + 8 * q4;
#pragma unroll
      for (int ks = 0; ks < 17; ++ks) qf[ks] = *(const bf16x8*)(qp + 32 * ks);
      WG_BAR();
      const unsigned char* ckv = p.ws + OFF_CKV + (size_t)(token >> 11) * SEQ * KVLD * 2;
      GATHER_DMA(ckv, 0, lds)
      DMA_WAIT(); WG_BAR(); }
#pragma nounroll
    for (int j = 0; j < nq; ++j) {
        const int token = bid + G * j, qpos = token & 2047, cnt = qpos + 1 < 256 ? qpos + 1 : 256;
        const bool has_nq = j + 1 < nq; const int token_n = token + G, qpos_n = token_n & 2047, cnt_n = qpos_n + 1 < 256 ? qpos_n + 1 : 256;
        bf16_t* qlat = (bf16_t*)(p.ws + OFF_D) + (size_t)token * QLD;
        const unsigned char* ckv = p.ws + OFF_CKV + (size_t)(token >> 11) * SEQ * KVLD * 2;
        const unsigned char* ckv_n = p.ws + OFF_CKV + (size_t)(token_n >> 11) * SEQ * KVLD * 2;
        const int sb = (j & 1) * 256, sbn = ((j + 1) & 1) * 256;
        int t2 = tid; asm volatile("" : "+v"(t2));
        const int l15b = t2 & 15, q4b = (t2 >> 4) & 3;
        if (has_nq && tid < 256) sels[sbn + tid] = tid < cnt_n ? (int)selg[(size_t)token_n * 256 + t2] : 0;
        WG_BAR();
        float lpart = 0.f; f32x4 O[4][2];
        float mref;
        { f32x4 qq = (f32x4){0.f, 0.f, 0.f, 0.f};
#pragma unroll
          for (int ks = 0; ks < 17; ++ks) qq = __builtin_amdgcn_mfma_f32_16x16x32_bf16(qf[ks], qf[ks], qq, 0, 0, 0);
          const int sel3 = l15 & 3; float d = sel3 == 0 ? qq[0] : (sel3 == 1 ? qq[1] : (sel3 == 2 ? qq[2] : qq[3]));
          d = (q4 == (l15 >> 2)) ? d : 0.f; d = sum_xor32(sum_xor16(d));
          mref = sqrtf(d * kmax2) * 1.01f + 1e-3f; }
#pragma unroll
        for (int c = 0; c < 4; ++c) { O[c][0] = (f32x4){0.f, 0.f, 0.f, 0.f}; O[c][1] = (f32x4){0.f, 0.f, 0.f, 0.f}; }
#pragma unroll
        for (int ch = 0; ch < 4; ++ch) {
            LAS unsigned char* Kc = lds + (ch & 1) * 70656; LAS unsigned char* Kn = lds + ((ch & 1) ^ 1) * 70656;
            if (ch < 3) GATHER_DMA(ckv, sb + 64 * (ch + 1), Kn) else if (has_nq) GATHER_DMA(ckv_n, sbn, Kn)
            f32x4 a = (f32x4){0.f, 0.f, 0.f, 0.f};
            const bool act = 64 * ch < cnt;
            if (act) { const unsigned sa = sa0 + (ch & 1) * 70656; bf16x8 k0, k1, k2, k3;
#define S4(K) LDSRD4(k0, k1, k2, k3, sa, (K) * 64, (K) * 64 + 64, (K) * 64 + 128, (K) * 64 + 192); \
              a = __builtin_amdgcn_mfma_f32_16x16x32_bf16(k0, qf[K], a, 0, 0, 0); a = __builtin_amdgcn_mfma_f32_16x16x32_bf16(k1, qf[(K) + 1], a, 0, 0, 0); \
              a = __builtin_amdgcn_mfma_f32_16x16x32_bf16(k2, qf[(K) + 2], a, 0, 0, 0); a = __builtin_amdgcn_mfma_f32_16x16x32_bf16(k3, qf[(K) + 3], a, 0, 0, 0);
              S4(0) S4(4) S4(8) S4(12)
#undef S4
              LDSRD1(k0, sa, 1024); a = __builtin_amdgcn_mfma_f32_16x16x32_bf16(k0, qf[16], a, 0, 0, 0); }
            asm volatile("" ::: "memory");
            if (ch == 3 && has_nq) { const bf16_t* qp = (const bf16_t*)(p.ws + OFF_D) + (size_t)token_n * QLD + (16 * ht + l15b) * 544 + 8 * q4b;
#pragma unroll
                for (int ks = 0; ks < 17; ++ks) qf[ks] = *(const bf16x8*)(qp + 32 * ks); }
            if (act) {
            f32x4 pv; float ps = 0.f;
#pragma unroll
            for (int i = 0; i < 4; ++i) { pv[i] = (64 * ch + 16 * kt + 4 * q4 + i) < cnt ? __builtin_amdgcn_exp2f(a[i] - mref) : 0.f; ps += pv[i]; }
            lpart += ps;
            *(LAS u32x2*)(Pl + (16 * ht + l15) * 144 + (16 * kt + 4 * q4) * 2) = pack4(pv);
            WG_BAR();
            { const unsigned vb = va0 + (ch & 1) * 70656; bf16x8 p0, p1; s16x4 t[4];
#define PVH(S2) LDSRD_PVA(p0, p1, t, pa0, vb, (S2) * 64, (S2) * 35328); \
              _Pragma("unroll") for (int c = 0; c < 2; ++c) { const bf16x8 vf = __builtin_shufflevector(t[2 * c], t[2 * c + 1], 0, 1, 2, 3, 4, 5, 6, 7); \
                  O[c][0] = __builtin_amdgcn_mfma_f32_16x16x32_bf16(vf, p0, O[c][0], 0, 0, 0); O[c][1] = __builtin_amdgcn_mfma_f32_16x16x32_bf16(vf, p1, O[c][1], 0, 0, 0); } \
              LDSRD_PVB(t, vb, (S2) * 35328); \
              _Pragma("unroll") for (int c = 0; c < 2; ++c) { const bf16x8 vf = __builtin_shufflevector(t[2 * c], t[2 * c + 1], 0, 1, 2, 3, 4, 5, 6, 7); \
                  O[2 + c][0] = __builtin_amdgcn_mfma_f32_16x16x32_bf16(vf, p0, O[2 + c][0], 0, 0, 0); O[2 + c][1] = __builtin_amdgcn_mfma_f32_16x16x32_bf16(vf, p1, O[2 + c][1], 0, 0, 0); }
              PVH(0) PVH(1)
#undef PVH
            }
            }
            DMA_WAIT(); WG_BAR();
        }
        lpart = sum_xor32(sum_xor16(lpart));
        if (q4 == 0) lred[kt * 32 + 16 * ht + l15] = lpart;
        WG_BAR();
        const float i0 = 1.f / (lred[l15] + lred[32 + l15] + lred[64 + l15] + lred[96 + l15]), i1 = 1.f / (lred[16 + l15] + lred[48 + l15] + lred[80 + l15] + lred[112 + l15]);
#pragma unroll
        for (int c = 0; c < 4; ++c) if (do_write) { *(u32x2*)(qlat + l15b * 512 + 64 * w + 16 * c + 4 * q4b) = pack4(O[c][0] * i0); *(u32x2*)(qlat + (16 + l15b) * 512 + 64 * w + 16 * c + 4 * q4b) = pack4(O[c][1] * i1); }
    }
#undef GATHER_DMA
#undef DMA_WAIT
}

#define XB_TMO      128
#define XB_XCNT(j)  (256  + 64 * (j))
#define XB_XSUB(j)  (1280 + 64 * (j))
#define XB_XGEN(j)  (2304 + 64 * (j))
#define XB_TOP      3328
#define XB_TOPGEN   3392
#define XCD_BAR_WORDS 3456
#define XB_SPIN_CAP (1u << 20)
__device__ __forceinline__ unsigned xb_ld(unsigned* p)              { return __hip_atomic_load(p, __ATOMIC_RELAXED, __HIP_MEMORY_SCOPE_AGENT); }
__device__ __forceinline__ unsigned xb_add(unsigned* p, unsigned v) { return __hip_atomic_fetch_add(p, v, __ATOMIC_RELAXED, __HIP_MEMORY_SCOPE_AGENT); }
__device__ __forceinline__ unsigned xb_xcc_id() { return (unsigned)__builtin_amdgcn_s_getreg((3 << 11) | 20) & 0xFu; }
#define XB_SPIN(cond, bar) do { unsigned _sp = 0; while (cond) { __builtin_amdgcn_s_sleep(1); \
    if ((++_sp & 255u) == 0u) { if (xb_ld(&(bar)[XB_TMO])) break; if (_sp > XB_SPIN_CAP) { atomicAdd(&(bar)[XB_TMO], 1u); break; } } } } while (0)
struct XcdBarrier { unsigned* bar; unsigned x; volatile LAS unsigned* st; };
__device__ __forceinline__ XcdBarrier xcd_barrier_post(unsigned* bar, volatile LAS unsigned* st) {
    XcdBarrier b; b.bar = bar; b.x = xb_xcc_id(); b.st = st;
    if (threadIdx.x == 0) (void)xb_add(&bar[XB_XCNT(b.x)], 1u);
    return b;
}
__device__ __forceinline__ uint2 xcd_barrier_complete(unsigned* bar, unsigned x) {
    const unsigned G = gridDim.x * gridDim.y * gridDim.z;
    unsigned sum, cnt, mine, sp = 0u;
    for (;;) {
        sum = 0u; cnt = 0u; mine = 0u;
#pragma unroll
        for (unsigned j = 0; j < 16; ++j) { const unsigned c = xb_ld(&bar[XB_XCNT(j)]); sum += c; cnt += (c > 0u) ? 1u : 0u; mine = (j == x) ? c : mine; }
        if (sum == G) break;
        __builtin_amdgcn_s_sleep(1);
        if ((++sp & 255u) == 0u) { if (xb_ld(&bar[XB_TMO])) break; if (sp > XB_SPIN_CAP) { atomicAdd(&bar[XB_TMO], 1u); break; } }
    }
    return make_uint2(mine > 0u ? mine : 1u, cnt > 0u ? cnt : 1u);
}
__device__ __forceinline__ void xcd_barrier(const XcdBarrier& b) {
    asm volatile("s_waitcnt vmcnt(0)" ::: "memory");
    __syncthreads();
    if (threadIdx.x == 0) {
        unsigned* bar = b.bar;
        __builtin_amdgcn_s_waitcnt(0);
        unsigned nloc = b.st[0], nx = b.st[1];
        if (nloc == 0u) { const uint2 r = xcd_barrier_complete(bar, b.x); nloc = r.x; nx = r.y; b.st[0] = nloc; b.st[1] = nx; }
        const unsigned old = xb_add(&bar[XB_XSUB(b.x)], 1u);
        const unsigned gen = old / nloc;
        if (old + 1u == (gen + 1u) * nloc) {
            __builtin_amdgcn_fence(__ATOMIC_RELEASE, "agent");
            asm volatile("s_waitcnt vmcnt(0)" ::: "memory");
            const unsigned og = xb_add(&bar[XB_TOP], 1u);
            const unsigned tg = og / nx;
            if (og + 1u == (tg + 1u) * nx) xb_add(&bar[XB_TOPGEN], 1u);
            else XB_SPIN(xb_ld(&bar[XB_TOPGEN]) == tg, bar);
            __builtin_amdgcn_fence(__ATOMIC_ACQUIRE, "agent");
            xb_add(&bar[XB_XGEN(b.x)], 1u);
            asm volatile("s_waitcnt vmcnt(0)" ::: "memory");
        } else {
            XB_SPIN(xb_ld(&bar[XB_XGEN(b.x)]) == gen, bar);
            __builtin_amdgcn_fence(__ATOMIC_ACQUIRE, "agent");
            asm volatile("s_waitcnt vmcnt(0)" ::: "memory");
        }
    }
    __syncthreads();
}

__global__ void __launch_bounds__(512, 2) fwd_megakernel(Params p) {
    extern __shared__ __attribute__((aligned(16))) unsigned char smem[];
    LAS unsigned char* lds = (LAS unsigned char*)smem;
    cg::grid_group grid = cg::this_grid();
    unsigned char* ws = p.ws; const int G = gridDim.x, bid = blockIdx.x;
    const float2* rope = (const float2*)(ws + OFF_ROPE);
    volatile LAS unsigned* xst = (volatile LAS unsigned*)(lds + LDS_BYTES - 16);
    if (threadIdx.x == 0) { xst[0] = 0u; xst[1] = 0u; }
    __syncthreads();
    const XcdBarrier xb = xcd_barrier_post((unsigned*)(ws + OFF_BAR), xst);
#ifdef ONLY
#define PHASE(n) if ((n) == ONLY)
#else
#define PHASE(n) if (p.ph_lo <= (n) && (n) <= p.ph_hi)
#endif
#define SYNC(n) if (p.ph_lo <= (n) && (n) < p.ph_hi) { if ((n) == 0) grid.sync(); else xcd_barrier(xb); }
#define REP(n) for (int _r = 0, _nr = 1 + ((p.rep >> (n)) & 1); _r < _nr; ++_r)
    PHASE(0) REP(0) { phase0(lds, p); __syncthreads(); }
    SYNC(0);
    PHASE(1) { Sched2D S{(const char*)(ws + OFF_B), (const char*)(ws + OFF_WIN0), (size_t)256 * 4096 * 2, (size_t)256 * 4096 * 2, 32, 48, G, bid};
        EpiProj0 E{(bf16_t*)(ws + OFF_A), rope}; gemm_phase(lds, 4096, 4096, 4096, S, E); }
    SYNC(1);
    PHASE(2) REP(2) { const int rb = (G == 256) ? xcd_run(bid, G) : bid; for (int it = bid; it < 256 + 1536; it += G) { if (it < 256) s5_item(lds, p, it); else dil_item(lds, p, it - 256 - bid + rb); } }
    SYNC(2);
    PHASE(3) { const int Gg = G >= 256 ? 128 : G / 2;
        Sched2D S{(const char*)(ws + OFF_YBUF), (const char*)(ws + OFF_WGLU), (size_t)256 * 1024 * 2, (size_t)256 * 1024 * 2, 32, 4, Gg, bid};
        EpiGlu E{(const bf16_t*)(ws + OFF_YBUF), (const bf16_t*)(ws + OFF_A), p.glu_b, (bf16_t*)(ws + OFF_MIX)}; gemm_phase(lds, 1024, 1024, 1024, S, E);
        if (bid >= Gg) merge_rows(p, bid - Gg, G - Gg); }
    SYNC(3);
    PHASE(4) { Sched2D S{(const char*)(ws + OFF_MIX), (const char*)(ws + OFF_WOUT0), (size_t)256 * 2048 * 2, (size_t)256 * 2048 * 2, 32, 16, G, bid};
        EpiResid E{p.x, p.out, (bf16_t*)(ws + OFF_B), (float*)(ws + OFF_SSQ)}; gemm_phase(lds, 2048, 2048, 2048, S, E); }
    SYNC(4);
    PHASE(5) { const float* ssq = (const float*)(ws + OFF_SSQ); float* rs1 = (float*)(ws + OFF_RS1);
        for (int row = bid * 512 + threadIdx.x; row < NTOK; row += G * 512) { float s = 0.f; for (int i = 0; i < 64; i += 4) { const f32x4 v = *(const f32x4*)(ssq + (size_t)row * 64 + i); s += (v.x + v.y) + (v.z + v.w); } rs1[row] = rsqrtf(s * (1.f / DM) + EPS); } }
    SYNC(5);
    PHASE(6) { { Sched2D S{(const char*)(ws + OFF_B), (const char*)(ws + OFF_WIN1), (size_t)256 * 4096 * 2, (size_t)256 * 4096 * 2, 32, 24, G, bid};
          EpiProj1 E{(bf16_t*)(ws + OFF_PROJ1), (const float*)(ws + OFF_RS1)}; gemm_phase(lds, 4096, 4096, 4096, S, E); }
        if (G >= 128) {
            if (bid < 64) { SchedGateSplit S{(const char*)(ws + OFF_B), (const char*)(ws + OFF_WIN1), bid}; EpiGatePart E{(float*)(ws + OFF_GP), (const float*)(ws + OFF_RS1)}; gemm_phase(lds, p.k2048, 4096, 4096, S, E); }
            else phase0b(lds, p, bid - 64, G - 64);
        } else { for (int c = bid; c < 64; c += G) { SchedGateSplit S{(const char*)(ws + OFF_B), (const char*)(ws + OFF_WIN1), c}; EpiGatePart E{(float*)(ws + OFF_GP), (const float*)(ws + OFF_RS1)}; gemm_phase(lds, p.k2048, 4096, 4096, S, E); }
            phase0b(lds, p, bid, G); } }
    SYNC(6);
    PHASE(7) phase7(lds, p);
    SYNC(7);
    PHASE(8) { Sched2D S{(const char*)(ws + OFF_PROJ1), (const char*)(ws + OFF_WQ), (size_t)256 * ODD_INP * 2, (size_t)256 * 1536 * 2, 32, 32, G, bid};
        EpiQ E{(bf16_t*)(ws + OFF_QBUF), (bf16_t*)(ws + OFF_B), (const float*)(ws + OFF_RSQ), rope, (bf16_t*)(ws + OFF_D)}; gemm_phase(lds, 1536, ODD_INP, 1536, S, E); }
    SYNC(8);
    PHASE(9) {
#ifndef NO9A
 { SchedQlat S{(const char*)(ws + OFF_QBUF), (const char*)(ws + OFF_WUK), G, bid}; EpiQlat E{(bf16_t*)(ws + OFF_D), (const bf16_t*)(ws + OFF_QBUF)}; gemm_phase(lds, p.k128, 4096, 128, S, E); }
#endif
#ifndef NO9B
        { SchedIdx S{(const char*)(ws + OFF_B), (const char*)(ws + OFF_KIDX), G, bid}; EpiIdx E{(float*)(ws + OFF_ISC), (const float*)(ws + OFF_WIDX), (f32x4){0.f, 0.f, 0.f, 0.f}, (f32x4){0.f, 0.f, 0.f, 0.f}, -1}; gemm_phase(lds, p.k128, 128, 128, S, E); }
#endif
 }
    SYNC(9);
    PHASE(10) { const int wid = threadIdx.x >> 6;
#ifndef NO_TOPK
        REP(10) { topk_phase(p); }
#endif
        __threadfence_block(); __syncthreads();
#ifndef NO_DSA
        REP(11) { dsa_phase(lds, p, _r == _nr - 1); __syncthreads(); }
#endif
 }
    SYNC(10);
    PHASE(11) { SchedOVd S{(const char*)(ws + OFF_D), (const char*)(ws + OFF_WUV), G, bid}; EpiOVd E{(bf16_t*)(ws + OFF_B), (const bf16_t*)(ws + OFF_PROJ1), (const float*)(ws + OFF_GP)}; gemm_phase(lds, p.k512, QLD, 512, S, E); }
    SYNC(11);
    PHASE(12) { Sched2D S{(const char*)(ws + OFF_B), (const char*)(ws + OFF_WOUT1), (size_t)256 * 4096 * 2, (size_t)256 * 4096 * 2, 32, 16, G, bid};
        EpiResid E{p.out, p.out, nullptr, (float*)(ws + OFF_SSQ)}; gemm_phase(lds, 4096, 4096, 4096, S, E); }
    SYNC(12);
    PHASE(13) { const float* ssq = (const float*)(ws + OFF_SSQ); const int lane = threadIdx.x & 63, wid = threadIdx.x >> 6;
        for (int row = bid * 8 + wid; row < NTOK; row += G * 8) { const float s = wave_sum(ssq[(size_t)row * 64 + lane]); const float rs = rsqrtf(s * (1.f / DM) + EPS); float* o = p.out + (size_t)row * DM;
#pragma unroll 4
            for (int i = 0; i < 16; ++i) { const int c = (i * 64 + lane) * 4; const f32x4 g = *(const f32x4*)(p.final_norm + c); *(f32x4*)(o + c) = *(const f32x4*)(o + c) * rs * g; } } }
}

#ifndef REPMASK
#define REPMASK 0
#endif
extern "C" void kernel_launch(void* const* d_in, const int* in_sizes, int n_in, void* d_out, int out_size, void* d_ws, size_t ws_size, hipStream_t stream) {
    static int grid_blocks = 0;
    if (!grid_blocks) {
        int dev = 0, cus = 0, per_cu = 0;
        hipGetDevice(&dev);
        hipDeviceGetAttribute(&cus, hipDeviceAttributeMultiprocessorCount, dev);
        hipFuncSetAttribute((const void*)fwd_megakernel, hipFuncAttributeMaxDynamicSharedMemorySize, LDS_BYTES);
        hipOccupancyMaxActiveBlocksPerMultiprocessor(&per_cu, fwd_megakernel, 512, LDS_BYTES);
        if (per_cu > 1) per_cu = 1;
        grid_blocks = cus * per_cu;
        if (ws_size < OFF_END) fprintf(stderr, "workspace too small: %zu < %zu\n", ws_size, (size_t)OFF_END);
    }
    Params p{};
    const float** f = (const float**)&p;
    for (int i = 0; i < 25; ++i) f[i] = (const float*)d_in[i];
    p.out = (float*)d_out; p.ws = (unsigned char*)d_ws; p.ph_lo = 0; p.ph_hi = 13; p.k128 = 128; p.rep = REPMASK; p.k2048 = 2048; p.k512 = 512;
    hipMemsetAsync((unsigned char*)d_ws + OFF_BAR, 0, XCD_BAR_WORDS * 4, stream);
    void* args[] = {&p};
    hipError_t e = hipLaunchCooperativeKernel((void*)fwd_megakernel, dim3(grid_blocks), dim3(512), args, LDS_BYTES, stream);
    if (e != hipSuccess) fprintf(stderr, "cooperative launch failed: %s (grid %d)\n", hipGetErrorString(e), grid_blocks);
}
```
